# Optimizing an MI355X kernel written in HIP

```python
import math
import jax, jax.numpy as jnp
from jax import lax
import numpy as np

D_MODEL = 1024
BATCH = 16
SEQ = 256
DEPTH = 1
DEC_BATCH = 4
DEC_SEQ = 1024
PAST_LEN = 512

GRID_W = 64
ATTN_HEADS = 8
ATTN_DH = 64
ATTN_VD = 2 * ATTN_DH
ROPE_BASE = 10000.0
ROPE_AXIS_DIM = ATTN_DH // 2
Q_BLOCK = 128
D_INNER = 2 * D_MODEL
SSM_HEADDIM = 64
SSM_HEADS = D_INNER // SSM_HEADDIM
SSM_GROUPS = 8
SSM_STATE = 128
D_CONV = 5
CHUNK = 128
CONV_DIM = D_INNER + 2 * SSM_GROUPS * SSM_STATE
D_FF = ((8 * D_MODEL // 3 + 255) // 256) * 256
W_Q = ATTN_HEADS * 2 * ATTN_DH
W_K = ATTN_HEADS * 2 * ATTN_DH
W_V = ATTN_HEADS * ATTN_VD
W_Z = D_INNER
W_XBC = CONV_DIM
W_DT = 2 * SSM_HEADS
W_GATES = 2 * D_MODEL
D_IN_TOTAL = W_Q + W_K + W_V + W_Z + W_XBC + W_DT + W_GATES
EPS = 1e-6

kernel_name = "hybrid_diffattn_ssd_prefix_context_step"


def rms_norm(x, g):
    xf = x.astype(jnp.float32)
    y = xf * lax.rsqrt(jnp.mean(xf * xf, axis=-1, keepdims=True) + EPS)
    return (y * g.astype(jnp.float32)).astype(x.dtype)


def axial_rope_tables(n_tok):
    rows = n_tok // GRID_W
    row = jnp.repeat(jnp.arange(rows, dtype=jnp.float32), GRID_W)
    col = jnp.tile(jnp.arange(GRID_W, dtype=jnp.float32), rows)
    inv = ROPE_BASE ** (-jnp.arange(0, ROPE_AXIS_DIM, 2, dtype=jnp.float32) / ROPE_AXIS_DIM)
    ang_r = row[:, None] * inv[None, :]
    ang_c = col[:, None] * inv[None, :]
    return jnp.cos(ang_r), jnp.sin(ang_r), jnp.cos(ang_c), jnp.sin(ang_c)


def _rotate(x, cos, sin):
    x1, x2 = jnp.split(x, 2, axis=-1)
    cos = cos[None, :, None, None, :]
    sin = sin[None, :, None, None, :]
    return jnp.concatenate([x1 * cos - x2 * sin, x2 * cos + x1 * sin], axis=-1)


def apply_axial_rope(x, rope):
    cos_r, sin_r, cos_c, sin_c = rope
    xf = x.astype(jnp.float32)
    xr = _rotate(xf[..., :ROPE_AXIS_DIM], cos_r, sin_r)
    xc = _rotate(xf[..., ROPE_AXIS_DIM:], cos_c, sin_c)
    return jnp.concatenate([xr, xc], axis=-1).astype(x.dtype)


def diff_attention(q, k, v, lam):
    b, lq, h, _, dh = q.shape
    nb = lq // Q_BLOCK
    qb = jnp.moveaxis(q.reshape(b, nb, Q_BLOCK, h, 2, dh), 1, 0)
    scale = dh ** -0.5

    def one_block(qblk):
        s = jnp.einsum("bqhcd,bkhcd->bhcqk", qblk, k).astype(jnp.float32) * scale
        p = jax.nn.softmax(s, axis=-1)
        w = (p[:, :, 0] - lam * p[:, :, 1]).astype(v.dtype)
        return jnp.einsum("bhqk,bkhe->bqhe", w, v)

    o = lax.map(one_block, qb)
    return jnp.moveaxis(o, 0, 1).reshape(b, lq, h, v.shape[-1])


def centred_dwconv(x, w, bias):
    y = lax.conv_general_dilated(
        x, w[:, None, :].astype(x.dtype), window_strides=(1,),
        padding=[(D_CONV // 2, D_CONV // 2)],
        dimension_numbers=("NWC", "WIO", "NWC"),
        feature_group_count=x.shape[-1])
    return y + bias


def _segsum(a):
    t = a.shape[-1]
    cs = jnp.cumsum(a, axis=-1)
    diff = cs[..., :, None] - cs[..., None, :]
    mask = jnp.tril(jnp.ones((t, t), dtype=bool))
    return jnp.where(mask, diff, -jnp.inf)


def ssd_scan(x, dt, A, Bm, Cm, h0):
    b, L, H, P = x.shape
    G, N = Bm.shape[2], Bm.shape[3]
    R = H // G
    nc = L // CHUNK
    x = x.astype(jnp.float32)
    xd = (x * dt[..., None]).reshape(b, nc, CHUNK, G, R, P)
    a = (dt * A).reshape(b, nc, CHUNK, G, R).transpose(0, 3, 4, 1, 2)
    Bc = Bm.astype(jnp.float32).reshape(b, nc, CHUNK, G, N)
    Cc = Cm.astype(jnp.float32).reshape(b, nc, CHUNK, G, N)
    a_cum = jnp.cumsum(a, axis=-1)
    Lmat = jnp.exp(_segsum(a))
    CB = jnp.einsum("bclgn,bcsgn->bgcls", Cc, Bc)
    y_diag = jnp.einsum("bgcls,bgrcls,bcsgrp->bclgrp", CB, Lmat, xd)
    decay_states = jnp.exp(a_cum[..., -1:] - a_cum)
    states = jnp.einsum("bclgn,bgrcl,bclgrp->bcgrpn", Bc, decay_states, xd)
    states = jnp.concatenate([h0.astype(jnp.float32).reshape(b, 1, G, R, P, N), states], axis=1)
    chunk_a = jnp.pad(a_cum[..., -1], ((0, 0), (0, 0), (0, 0), (1, 0)))
    decay_chunk = jnp.exp(_segsum(chunk_a))
    new_states = jnp.einsum("bgrzc,bcgrpn->bzgrpn", decay_chunk, states)
    prev_states, final = new_states[:, :-1], new_states[:, -1]
    y_off = jnp.einsum("bclgn,bcgrpn,bgrcl->bclgrp", Cc, prev_states, jnp.exp(a_cum))
    y = (y_diag + y_off).reshape(b, L, H, P)
    return y, final.reshape(b, H, P, N)


def ada_mod(cond, w_ada, b_ada):
    return (jax.nn.silu(cond) @ w_ada + b_ada)[:, None, :]


def trunk_layer(x, mod, rope, ctx_k, ctx_v, h0_f, h0_b, lam_init,
                norm1_g, norm2_g, w_in, q_norm_g, k_norm_g,
                lambda_q1, lambda_k1, lambda_q2, lambda_k2, attn_sub_g,
                conv_w, conv_b, A_log, dt_bias, D_skip, ssm_norm_g,
                w_branch_a, w_branch_b, w_out, w_ffn_gate, w_ffn_up, w_ffn_down):
    b, L, _ = x.shape
    shift1, scale1, gate1, shift2, scale2, gate2 = jnp.split(mod, 6, axis=-1)
    h = rms_norm(x, norm1_g) * (1 + scale1) + shift1
    splits = [W_Q, W_Q + W_K, W_Q + W_K + W_V, W_Q + W_K + W_V + W_Z,
              W_Q + W_K + W_V + W_Z + W_XBC, W_Q + W_K + W_V + W_Z + W_XBC + W_DT]
    q, k, v, z, xbc, dt_raw, gates = jnp.split(h @ w_in, splits, axis=-1)

    q = rms_norm(q.reshape(b, L, ATTN_HEADS, 2, ATTN_DH), q_norm_g)
    k = rms_norm(k.reshape(b, L, ATTN_HEADS, 2, ATTN_DH), k_norm_g)
    v = v.reshape(b, L, ATTN_HEADS, ATTN_VD)
    if rope is None:
        keys, vals = k, v
    else:
        q = apply_axial_rope(q, rope)
        keys = jnp.concatenate([apply_axial_rope(k, rope), ctx_k.astype(k.dtype)], axis=1)
        vals = jnp.concatenate([v, ctx_v.astype(v.dtype)], axis=1)
    lam = (jnp.exp(jnp.sum(lambda_q1.astype(jnp.float32) * lambda_k1.astype(jnp.float32)))
           - jnp.exp(jnp.sum(lambda_q2.astype(jnp.float32) * lambda_k2.astype(jnp.float32)))
           + lam_init)
    o = diff_attention(q, keys, vals, lam)
    o = rms_norm(o, attn_sub_g) * (1.0 - lam_init)
    out_a = o.reshape(b, L, ATTN_HEADS * ATTN_VD) @ w_branch_a

    xbc = jax.nn.silu(centred_dwconv(xbc, conv_w, conv_b))
    xs, Bs, Cs = jnp.split(xbc, [D_INNER, D_INNER + SSM_GROUPS * SSM_STATE], axis=-1)
    xs = xs.reshape(b, L, SSM_HEADS, SSM_HEADDIM)
    Bs = Bs.reshape(b, L, SSM_GROUPS, SSM_STATE)
    Cs = Cs.reshape(b, L, SSM_GROUPS, SSM_STATE)
    dt = jax.nn.softplus(dt_raw.astype(jnp.float32).reshape(b, L, 2, SSM_HEADS)
                         + dt_bias.astype(jnp.float32))
    A = -jnp.exp(A_log.astype(jnp.float32))
    if h0_f is None:
        h0_f = jnp.zeros((b, SSM_HEADS, SSM_HEADDIM, SSM_STATE), jnp.float32)
        h0_b = jnp.zeros((b, SSM_HEADS, SSM_HEADDIM, SSM_STATE), jnp.float32)
    y_f, hf = ssd_scan(xs, dt[:, :, 0], A[0], Bs, Cs, h0_f)
    y_b, hb = ssd_scan(jnp.flip(xs, 1), jnp.flip(dt[:, :, 1], 1), A[1],
                       jnp.flip(Bs, 1), jnp.flip(Cs, 1), h0_b)
    y = y_f + jnp.flip(y_b, 1) + D_skip.astype(jnp.float32)[:, None] * xs.astype(jnp.float32)
    y = rms_norm(y.reshape(b, L, D_INNER).astype(x.dtype) * jax.nn.silu(z), ssm_norm_g)
    out_b = y @ w_branch_b

    g_a, g_b = jnp.split(gates, 2, axis=-1)
    merged = jax.nn.sigmoid(g_a) * out_a + jax.nn.sigmoid(g_b) * out_b
    x = x + gate1 * (merged @ w_out)

    h2 = rms_norm(x, norm2_g) * (1 + scale2) + shift2
    x = x + gate2 * ((jax.nn.silu(h2 @ w_ffn_gate) * (h2 @ w_ffn_up)) @ w_ffn_down)
    return x, k, v, hf.astype(x.dtype), hb.astype(x.dtype)


def setup_inputs(seed: int = 0) -> dict:
    key = jax.random.key(seed)
    ks = jax.random.split(key, 40)
    f32 = jnp.float32

    def nrm(i, shape, scale):
        return jax.random.normal(ks[i], shape, f32) * scale

    dt0 = jnp.exp(jax.random.uniform(ks[30], (DEPTH, 2, SSM_HEADS), f32,
                                     math.log(1e-3), math.log(1e-1)))
    return {
        "x_prompt": nrm(0, (BATCH, SEQ, D_MODEL), 1.0),
        "x_sample": nrm(1, (DEC_BATCH, DEC_SEQ, D_MODEL), 1.0),
        "c": nrm(2, (DEC_BATCH, D_MODEL), 1.0),
        "cache_k": nrm(3, (DEC_BATCH, DEPTH, PAST_LEN, ATTN_HEADS, 2, ATTN_DH), 1.0),
        "cache_v": nrm(4, (DEC_BATCH, DEPTH, PAST_LEN, ATTN_HEADS, ATTN_VD), 1.0),
        "state_ssm_fwd": nrm(5, (DEC_BATCH, DEPTH, SSM_HEADS, SSM_HEADDIM, SSM_STATE), 0.1),
        "state_ssm_bwd": nrm(6, (DEC_BATCH, DEPTH, SSM_HEADS, SSM_HEADDIM, SSM_STATE), 0.1),
        "c_ctx": nrm(7, (D_MODEL,), 1.0),
        "norm1_g": 1.0 + nrm(8, (DEPTH, D_MODEL), 0.05),
        "norm2_g": 1.0 + nrm(9, (DEPTH, D_MODEL), 0.05),
        "w_ada": nrm(10, (DEPTH, D_MODEL, 6 * D_MODEL), 0.5 * D_MODEL ** -0.5),
        "b_ada": nrm(11, (DEPTH, 6 * D_MODEL), 0.02),
        "w_in": nrm(12, (DEPTH, D_MODEL, D_IN_TOTAL), D_MODEL ** -0.5),
        "q_norm_g": 1.0 + nrm(13, (DEPTH, ATTN_DH), 0.05),
        "k_norm_g": 1.0 + nrm(14, (DEPTH, ATTN_DH), 0.05),
        "lambda_q1": nrm(15, (DEPTH, ATTN_DH), 0.1),
        "lambda_k1": nrm(16, (DEPTH, ATTN_DH), 0.1),
        "lambda_q2": nrm(17, (DEPTH, ATTN_DH), 0.1),
        "lambda_k2": nrm(18, (DEPTH, ATTN_DH), 0.1),
        "attn_sub_g": 1.0 + nrm(19, (DEPTH, ATTN_VD), 0.05),
        "conv_w": nrm(20, (DEPTH, D_CONV, CONV_DIM), D_CONV ** -0.5),
        "conv_b": nrm(21, (DEPTH, CONV_DIM), 0.02),
        "A_log": jnp.log(jax.random.uniform(ks[22], (DEPTH, 2, SSM_HEADS), f32, 1.0, 16.0)),
        "dt_bias": dt0 + jnp.log(-jnp.expm1(-dt0)),
        "D_skip": 1.0 + nrm(23, (DEPTH, SSM_HEADS), 0.05),
        "ssm_norm_g": 1.0 + nrm(24, (DEPTH, D_INNER), 0.05),
        "w_branch_a": nrm(25, (DEPTH, ATTN_HEADS * ATTN_VD, D_MODEL), (ATTN_HEADS * ATTN_VD) ** -0.5),
        "w_branch_b": nrm(26, (DEPTH, D_INNER, D_MODEL), D_INNER ** -0.5),
        "w_out": nrm(27, (DEPTH, D_MODEL, D_MODEL), D_MODEL ** -0.5),
        "w_ffn_gate": nrm(28, (DEPTH, D_MODEL, D_FF), D_MODEL ** -0.5),
        "w_ffn_up": nrm(29, (DEPTH, D_MODEL, D_FF), D_MODEL ** -0.5),
        "w_ffn_down": nrm(31, (DEPTH, D_FF, D_MODEL), D_FF ** -0.5),
    }


def reference(x_prompt, x_sample, c, cache_k, cache_v, state_ssm_fwd, state_ssm_bwd, c_ctx,
              norm1_g, norm2_g, w_ada, b_ada, w_in, q_norm_g, k_norm_g,
              lambda_q1, lambda_k1, lambda_q2, lambda_k2, attn_sub_g,
              conv_w, conv_b, A_log, dt_bias, D_skip, ssm_norm_g,
              w_branch_a, w_branch_b, w_out, w_ffn_gate, w_ffn_up, w_ffn_down):
    rope = axial_rope_tables(x_sample.shape[1])
    y_prompt = x_prompt
    y_sample = x_sample
    ks_, vs_, hfs, hbs = [], [], [], []
    for l in range(DEPTH):
        lam_init = 0.8 - 0.6 * math.exp(-0.3 * l)
        lw = dict(norm1_g=norm1_g[l], norm2_g=norm2_g[l], w_in=w_in[l],
                  q_norm_g=q_norm_g[l], k_norm_g=k_norm_g[l],
                  lambda_q1=lambda_q1[l], lambda_k1=lambda_k1[l],
                  lambda_q2=lambda_q2[l], lambda_k2=lambda_k2[l], attn_sub_g=attn_sub_g[l],
                  conv_w=conv_w[l], conv_b=conv_b[l], A_log=A_log[l], dt_bias=dt_bias[l],
                  D_skip=D_skip[l], ssm_norm_g=ssm_norm_g[l],
                  w_branch_a=w_branch_a[l], w_branch_b=w_branch_b[l], w_out=w_out[l],
                  w_ffn_gate=w_ffn_gate[l], w_ffn_up=w_ffn_up[l], w_ffn_down=w_ffn_down[l])
        mod_ctx = ada_mod(c_ctx[None, :], w_ada[l], b_ada[l])
        y_prompt, k_ctx, v_ctx, hf, hb = trunk_layer(
            y_prompt, mod_ctx, None, None, None, None, None, lam_init, **lw)
        ks_.append(k_ctx)
        vs_.append(v_ctx)
        hfs.append(hf)
        hbs.append(hb)
        mod_lat = ada_mod(c, w_ada[l], b_ada[l])
        y_sample, _, _, _, _ = trunk_layer(
            y_sample, mod_lat, rope, cache_k[:, l], cache_v[:, l],
            state_ssm_fwd[:, l], state_ssm_bwd[:, l], lam_init, **lw)
    new_cache_k = jnp.stack(ks_, axis=1)
    new_cache_v = jnp.stack(vs_, axis=1)
    new_state_ssm_fwd = jnp.stack(hfs, axis=1)
    new_state_ssm_bwd = jnp.stack(hbs, axis=1)
    return (y_prompt, y_sample, new_cache_k, new_cache_v, new_state_ssm_fwd, new_state_ssm_bwd)
```

```cpp
#include <hip/hip_runtime.h>
#include <hip/hip_cooperative_groups.h>
#include <cstdio>
namespace cg = cooperative_groups;

#define DI __device__ __forceinline__
typedef unsigned short bf16_t;
typedef short bf16x8 __attribute__((ext_vector_type(8)));
typedef short s16x4 __attribute__((ext_vector_type(4)));
typedef float f32x4 __attribute__((ext_vector_type(4)));
typedef float f32x2 __attribute__((ext_vector_type(2)));
typedef float f32x16 __attribute__((ext_vector_type(16)));
typedef unsigned u32x4 __attribute__((ext_vector_type(4)));
typedef unsigned u32x2 __attribute__((ext_vector_type(2)));
typedef __bf16 bf16v2 __attribute__((ext_vector_type(2)));

DI unsigned pk2(float a, float b) { f32x2 v = {a, b}; bf16v2 r = __builtin_convertvector(v, bf16v2); return __builtin_bit_cast(unsigned, r); }
DI float bflo(unsigned u) { return __uint_as_float(u << 16); }
DI float bfhi(unsigned u) { return __uint_as_float(u & 0xffff0000u); }
DI float sigm(float x) { return 1.0f / (1.0f + __expf(-x)); }
DI float silu(float x) { return x * sigm(x); }
#define MFMA32(a, b, c) __builtin_amdgcn_mfma_f32_32x32x16_bf16((a), (b), (c), 0, 0, 0)
DI f32x16 zero16() { f32x16 z; _Pragma("unroll") for (int i = 0; i < 16; ++i) z[i] = 0.f; return z; }
template <int S> DI bf16x8 pack8(const f32x16& x) {
    u32x4 p; p[0] = pk2(x[8 * S], x[8 * S + 1]); p[1] = pk2(x[8 * S + 2], x[8 * S + 3]); p[2] = pk2(x[8 * S + 4], x[8 * S + 5]); p[3] = pk2(x[8 * S + 6], x[8 * S + 7]);
    return __builtin_bit_cast(bf16x8, p);
}
DI bf16x8 cat4(s16x4 a, s16x4 b) { return __builtin_shufflevector(a, b, 0, 1, 2, 3, 4, 5, 6, 7); }
DI float wsum(float v) { _Pragma("unroll") for (int o = 32; o >= 1; o >>= 1) v += __shfl_xor(v, o); return v; }

namespace pg8 {
#define PG8_LAS __attribute__((address_space(3)))
typedef unsigned short bf16_t;
typedef short bf16x8 __attribute__((ext_vector_type(8)));
typedef float f32x4 __attribute__((ext_vector_type(4)));
typedef unsigned u32x4 __attribute__((ext_vector_type(4)));
constexpr int BM = 256, BK = 64, HALF = 128, HTB = HALF * BK * 2  , STAGE_BYTES = 8 * HTB, NXCD = 8, WGM = 8;

__host__ __device__ __forceinline__ int lds_byte(int r, int c) { const int st = (r >> 4) * 2 + (c >> 5), rr = r & 15, cc = c & 31, ob = rr * 64 + cc * 2; return st * 1024 + (ob ^ (((ob >> 9) & 1) << 5)); }
__host__ __device__ __forceinline__ void stage_rc(int b, int& R, int& C) { const int st = b / 1024, sb = b % 1024, swz = sb ^ (((sb >> 9) & 1) << 5); R = (st >> 1) * 16 + swz / 64; C = (st & 1) * 32 + (swz % 64) / 2; }
__host__ __device__ __forceinline__ int perm32(int rho) { const int n = rho >> 4, i = rho & 15; return 8 * (i >> 2) + 4 * n + (i & 3); }

struct Unit { int pm, pn; };
struct Gemm { const bf16_t* A; const bf16_t* Bt; int M, N, K; };

struct StaticOrder {
    int nM, nN, nwg, G, c;
    __host__ __device__ void init(int M, int N, int G_, int c_) { nM = M / BM; nN = N / BM; nwg = nM * nN; G = G_; c = c_; }
    __host__ __device__ bool next(int i, Unit& u) const {
        const long L = (long)i * G + c; if (L >= nwg) return false;
        int wgid = (int)L; { const int q = nwg / NXCD, r = nwg % NXCD, xcd = wgid % NXCD, off = wgid / NXCD; wgid = (xcd < r ? xcd * (q + 1) : r * (q + 1) + (xcd - r) * q) + off; }
        const int nig = WGM * nN, gid = wgid / nig, fm = gid * WGM, gsz = (nM - fm) < WGM ? (nM - fm) : WGM;
        u.pm = fm + ((wgid % nig) % gsz); u.pn = (wgid % nig) / gsz; return true;
    }
    __device__ __forceinline__ void a_ready(const Unit&) const {}
    __device__ __forceinline__ void done(const Unit&) const {}
};
template <class Epi, class Sched, bool STAMP = false>
__device__ __forceinline__ void gemm_phase(PG8_LAS unsigned char* lds, const Gemm g, const Sched& S, const Epi& E, unsigned long long* stamps) {
    int tid_l = threadIdx.x; asm volatile("" : "+v"(tid_l));
    const int tid = tid_l, wid = __builtin_amdgcn_readfirstlane(tid >> 6), lane = tid & 63, wr = wid >> 2, wc = wid & 3, fr = lane & 15, fq = lane >> 4;
    const int K = g.K, nt = K / BK;
    int ts_lo = 0, ts_hi = 0, nts = 0; const unsigned long long rt_entry = STAMP ? (unsigned long long)wall_clock64() : 0ull;
#define PG8_STAMP() do { if (STAMP && wid == 0 && nts < 64) { const unsigned long long _c = (unsigned long long)clock64(); \
        ts_lo = (lane == nts) ? (int)(unsigned)_c : ts_lo; ts_hi = (lane == nts) ? (int)(unsigned)(_c >> 32) : ts_hi; ++nts; } } while (0)
    PG8_STAMP();
    unsigned voffA[2], voffB[2];
#pragma unroll
    for (int i = 0; i < 2; ++i) { int R, C; stage_rc(tid * 16 + i * 8192, R, C); const int Rb = Epi::PERM ? ((R & ~31) + perm32(R & 31)) : R;
        voffA[i] = (unsigned)(R * K + C) * 2u; voffB[i] = (unsigned)(Rb * K + C) * 2u; }
    const size_t kstep = (size_t)(BK * 2);
    const size_t hstep = (size_t)HALF * K * 2;
    const size_t tstep = 2 * hstep;
    const unsigned ldsw = (unsigned)wid * 1024u;
    const int aoff = lds_byte(wr * 64 + fr, fq * 8), boff = lds_byte(wc * 32 + fr, fq * 8);
#define PG8_SA(b, h) (((b) * 2 + (h)) * HTB)
#define PG8_SB(b, h) ((4 + (b) * 2 + (h)) * HTB)
#define PG8_STAGE(bufoff, gbase, voff) do { _Pragma("unroll") for (int _i = 0; _i < 2; ++_i) \
        __builtin_amdgcn_global_load_lds((const unsigned*)((const char*)(gbase) + (voff)[_i]), (PG8_LAS unsigned*)(lds + (bufoff) + ldsw + _i * 8192), 16, 0, 0); } while (0)
#define PG8_LDA(dst, b, h) do { _Pragma("unroll") for (int m = 0; m < 4; ++m) _Pragma("unroll") for (int k = 0; k < 2; ++k) dst[m][k] = *(const PG8_LAS bf16x8*)(lds + PG8_SA(b, h) + aoff + m * 2048 + k * 1024); } while (0)
#define PG8_LDB(dst, b, h) do { _Pragma("unroll") for (int n = 0; n < 2; ++n) _Pragma("unroll") for (int k = 0; k < 2; ++k) dst[n][k] = *(const PG8_LAS bf16x8*)(lds + PG8_SB(b, h) + boff + n * 2048 + k * 1024); } while (0)
#define PG8_MMA(ai, bj, At, Bt) do { __builtin_amdgcn_s_setprio(1); _Pragma("unroll") for (int m = 0; m < 4; ++m) _Pragma("unroll") for (int n = 0; n < 2; ++n) _Pragma("unroll") for (int k = 0; k < 2; ++k) \
        acc[ai][bj][m][n] = __builtin_amdgcn_mfma_f32_16x16x32_bf16(Bt[n][k], At[m][k], acc[ai][bj][m][n], 0, 0, 0); __builtin_amdgcn_s_setprio(0); } while (0)
#define PG8_WAIT_V(n) asm volatile("s_waitcnt vmcnt(" #n ")" ::: "memory")
#define PG8_WAIT_L(n) asm volatile("s_waitcnt lgkmcnt(" #n ")" ::: "memory")
#define PG8_BAR __builtin_amdgcn_s_barrier()
#define PG8_SCHED __builtin_amdgcn_sched_barrier(0)
    Unit cur, nxt; int ui = 0;
    if (!S.next(0, cur)) return;
    f32x4 acc[2][2][4][2];
#pragma unroll
    for (int a = 0; a < 2; ++a)
#pragma unroll
        for (int b = 0; b < 2; ++b)
#pragma unroll
            for (int m = 0; m < 4; ++m)
#pragma unroll
                for (int n = 0; n < 2; ++n) acc[a][b][m][n] = (f32x4){0.f, 0.f, 0.f, 0.f};
    bf16x8 At[4][2], B0[2][2], B1[2][2];
    const char* cA = (const char*)g.A + (size_t)cur.pm * tstep; const char* cB = (const char*)g.Bt + (size_t)cur.pn * tstep;
    S.a_ready(cur);
    PG8_STAGE(PG8_SB(0, 0), cB, voffB); PG8_STAGE(PG8_SA(0, 0), cA, voffA); PG8_STAGE(PG8_SB(0, 1), cB + hstep, voffB); PG8_STAGE(PG8_SA(0, 1), cA + hstep, voffA);
    if (wr == 1) PG8_BAR;
    PG8_WAIT_V(4); PG8_BAR;
    PG8_STAGE(PG8_SB(1, 0), cB + kstep, voffB); PG8_STAGE(PG8_SA(1, 0), cA + kstep, voffA); PG8_STAGE(PG8_SB(1, 1), cB + hstep + kstep, voffB);
    PG8_WAIT_V(6); PG8_BAR;
    PG8_STAMP();
    for (;;) {
        const bool has_next = S.next(ui + 1, nxt);
        const char* nA = has_next ? (const char*)g.A + (size_t)nxt.pm * tstep : cA; const char* nB = has_next ? (const char*)g.Bt + (size_t)nxt.pn * tstep : cB;
        for (int t = 0; t < nt; t += 2) {
            const bool last = (t == nt - 2);
            const char* a1 = cA + (size_t)(t + 1) * kstep;
            const char* a2 = last ? nA : cA + (size_t)(t + 2) * kstep; const char* b2 = last ? nB : cB + (size_t)(t + 2) * kstep;
            const char* a3 = a2 + kstep; const char* b3 = b2 + kstep;
            if (last && has_next) S.a_ready(nxt);
            PG8_LDB(B0, 0, 0); PG8_SCHED; PG8_LDA(At, 0, 0); PG8_STAGE(PG8_SA(1, 1), a1 + hstep, voffA);
            PG8_WAIT_L(8); PG8_BAR; PG8_WAIT_L(0); PG8_MMA(0, 0, At, B0); PG8_BAR; PG8_SCHED;
            PG8_LDB(B1, 0, 1); PG8_STAGE(PG8_SB(0, 0), b2, voffB);
            PG8_BAR; PG8_WAIT_L(0); PG8_MMA(0, 1, At, B1); PG8_BAR;
            PG8_LDA(At, 0, 1); PG8_STAGE(PG8_SA(0, 0), a2, voffA);
            PG8_BAR; PG8_WAIT_L(0); PG8_MMA(1, 0, At, B0); PG8_BAR; PG8_SCHED;
            PG8_STAGE(PG8_SB(0, 1), b2 + hstep, voffB);
            PG8_WAIT_V(6); PG8_BAR; PG8_MMA(1, 1, At, B1); PG8_BAR;
            PG8_LDB(B0, 1, 0); PG8_SCHED; PG8_LDA(At, 1, 0); PG8_STAGE(PG8_SA(0, 1), a2 + hstep, voffA);
            PG8_WAIT_L(8); PG8_BAR; PG8_WAIT_L(0); PG8_MMA(0, 0, At, B0); PG8_BAR; PG8_SCHED;
            PG8_LDB(B1, 1, 1); PG8_STAGE(PG8_SB(1, 0), b3, voffB);
            PG8_BAR; PG8_WAIT_L(0); PG8_MMA(0, 1, At, B1); PG8_BAR;
            PG8_LDA(At, 1, 1); PG8_STAGE(PG8_SA(1, 0), a3, voffA);
            PG8_BAR; PG8_WAIT_L(0); PG8_MMA(1, 0, At, B0); PG8_BAR; PG8_SCHED;
            PG8_STAGE(PG8_SB(1, 1), b3 + hstep, voffB);
            PG8_WAIT_V(6); PG8_BAR; PG8_MMA(1, 1, At, B1); PG8_BAR;
        }
        PG8_STAMP();
        if constexpr (!Epi::AFTER_DRAIN) { E(acc, cur, wr, wc, fr, fq); S.done(cur); }
        PG8_STAMP();
        if (!has_next) break;
#pragma unroll
        for (int a = 0; a < 2; ++a)
#pragma unroll
            for (int b = 0; b < 2; ++b)
#pragma unroll
                for (int m = 0; m < 4; ++m)
#pragma unroll
                    for (int n = 0; n < 2; ++n) acc[a][b][m][n] = (f32x4){0.f, 0.f, 0.f, 0.f};
        cur = nxt; cA = nA; cB = nB; ++ui;
    }
    PG8_WAIT_V(0);
    if (wr == 0) PG8_BAR;
    PG8_BAR;
    if constexpr (Epi::AFTER_DRAIN) { E.fused(acc, cur, wr, wc, fr, fq, lds, wid, lane); S.done(cur); }
    PG8_STAMP();
    if (STAMP && wid == 0) { stamps[lane] = lane < nts ? (((unsigned long long)(unsigned)ts_hi << 32) | (unsigned)ts_lo) : 0ull;
        if (lane == 62) stamps[62] = rt_entry; if (lane == 63) stamps[63] = (unsigned long long)wall_clock64(); }
#undef PG8_STAMP
#undef PG8_SA
#undef PG8_SB
#undef PG8_STAGE
#undef PG8_LDA
#undef PG8_LDB
#undef PG8_MMA
#undef PG8_WAIT_V
#undef PG8_WAIT_L
#undef PG8_BAR
#undef PG8_SCHED
}
}

#ifndef PHMASK
#define PHMASK 0xffffffffu
#endif
constexpr int NTHR = 512;
constexpr int TOK = 8192;
constexpr float EPSF = 1e-6f;
constexpr size_t MiB = 1048576;
constexpr size_t WS_MOD = 0, WS_ATOT = 131072;
constexpr size_t WS_G = 1 * MiB, WS_TAB = 33 * MiB, WS_DT = 41 * MiB, WS_OATT = 43 * MiB;
constexpr size_t WS_HB = 59 * MiB, WS_BT = 59 * MiB, WS_YG = 59 * MiB;
constexpr size_t WS_WIN = 75 * MiB, WS_BN = 75 * MiB;
constexpr size_t WS_QK = 98 * MiB, WS_Z = 98 * MiB, WS_ACT = 98 * MiB;
constexpr size_t WS_V = 130 * MiB, WS_XBC = 130 * MiB, WS_YD = 130 * MiB, WS_MA = 130 * MiB;
constexpr size_t WS_QN = 146 * MiB, WS_KNI = 162 * MiB, WS_KNII = 170 * MiB, WS_VTI = 182 * MiB, WS_VTII = 190 * MiB;
constexpr size_t WS_YF = 162 * MiB, WS_MERGED = 162 * MiB, WS_H2 = 178 * MiB;
constexpr size_t WS_CN = 194 * MiB, WS_WD = 194 * MiB, WS_WA = 200 * MiB, WS_WB = 202 * MiB, WS_WOUT = 206 * MiB;
constexpr size_t WS_YB = 210 * MiB, WS_WGU = 242 * MiB;
constexpr size_t TABSZ = 64 * 8192;
constexpr int LDS_BYTES = 131072 + 1024;

struct Params { const float* in[32]; float* out; unsigned char* ws; };

using pg8::Unit;
struct EpiIn1 {
    static constexpr bool PERM = true, AFTER_DRAIN = false;
    bf16_t* qk; bf16_t* v; bf16_t* g; float* dt; float* ncv;
    DI void operator()(const f32x4 (&acc)[2][2][4][2], const Unit& u, int wr, int wc, int fr, int fq) const {
        const int row0 = u.pm * 256 + wr * 64 + fr, cl = wc * 32 + 8 * fq, pn = u.pn;
        if (pn == 20) {
            if (wc < 2) {
#pragma unroll
                for (int ai = 0; ai < 2; ++ai)
#pragma unroll
                    for (int m = 0; m < 4; ++m) { float* d = dt + (size_t)(row0 + ai * 128 + m * 16) * 64 + cl; *(f32x4*)d = acc[ai][0][m][0]; *(f32x4*)(d + 4) = acc[ai][0][m][1]; }
            }
            return;
        }
        bf16_t* base; int ld;
        if (pn < 8) { base = qk + pn * 256; ld = 2048; } else if (pn < 12) { base = v + (pn - 8) * 256; ld = 1024; } else { base = g + (pn - 12) * 256; ld = 2048; }
        const bool isg = pn >= 12, isv = (pn >= 8 && pn < 12 && u.pm < 16);
#pragma unroll
        for (int ai = 0; ai < 2; ++ai)
#pragma unroll
            for (int m = 0; m < 4; ++m) {
                const int row = row0 + ai * 128 + m * 16;
#pragma unroll
                for (int bj = 0; bj < 2; ++bj) {
                    f32x4 v0 = acc[ai][bj][m][0], v1 = acc[ai][bj][m][1];
                    if (isv) { float* o = ncv + (size_t)row * 1024 + (pn - 8) * 256 + bj * 128 + cl; *(f32x4*)o = v0; *(f32x4*)(o + 4) = v1; }
                    if (isg) {
#pragma unroll
                        for (int j = 0; j < 4; ++j) { v0[j] = sigm(v0[j]); v1[j] = sigm(v1[j]); } }
                    u32x4 w; w[0] = pk2(v0[0], v0[1]); w[1] = pk2(v0[2], v0[3]); w[2] = pk2(v1[0], v1[1]); w[3] = pk2(v1[2], v1[3]);
                    *(u32x4*)(base + (size_t)row * ld + bj * 128 + cl) = w;
                }
            }
    }
};
struct EpiIn2 {
    static constexpr bool PERM = true, AFTER_DRAIN = false;
    bf16_t* z; bf16_t* xbc;
    DI void operator()(const f32x4 (&acc)[2][2][4][2], const Unit& u, int wr, int wc, int fr, int fq) const {
        const int row0 = u.pm * 256 + wr * 64 + fr, cl = wc * 32 + 8 * fq, pn = u.pn;
        bf16_t* base; int ld;
        if (pn < 8) { base = z + pn * 256; ld = 2048; } else { base = xbc + (pn - 8) * 256; ld = 4096; }
#pragma unroll
        for (int ai = 0; ai < 2; ++ai)
#pragma unroll
            for (int m = 0; m < 4; ++m) {
                const int row = row0 + ai * 128 + m * 16;
#pragma unroll
                for (int bj = 0; bj < 2; ++bj) {
                    const f32x4 v0 = acc[ai][bj][m][0], v1 = acc[ai][bj][m][1];
                    u32x4 w; w[0] = pk2(v0[0], v0[1]); w[1] = pk2(v0[2], v0[3]); w[2] = pk2(v1[0], v1[1]); w[3] = pk2(v1[2], v1[3]);
                    *(u32x4*)(base + (size_t)row * ld + bj * 128 + cl) = w;
                }
            }
    }
};
template <int SECOND> struct EpiBranch {
    static constexpr bool PERM = false, AFTER_DRAIN = false;
    const bf16_t* g; float* ma; bf16_t* merged;
    DI void operator()(const f32x4 (&acc)[2][2][4][2], const Unit& u, int wr, int wc, int fr, int fq) const {
        const int row0 = u.pm * 256 + wr * 64 + fr, col0 = u.pn * 256 + wc * 32 + 4 * fq;
#pragma unroll
        for (int ai = 0; ai < 2; ++ai)
#pragma unroll
            for (int m = 0; m < 4; ++m) {
                const int row = row0 + ai * 128 + m * 16;
#pragma unroll
                for (int bj = 0; bj < 2; ++bj)
#pragma unroll
                    for (int n = 0; n < 2; ++n) {
                        const int c = col0 + bj * 128 + n * 16;
                        const u32x2 gg = *(const u32x2*)(g + (size_t)row * 2048 + SECOND * 1024 + c);
                        const f32x4 a = acc[ai][bj][m][n];
                        f32x4 r; r[0] = bflo(gg[0]) * a[0]; r[1] = bfhi(gg[0]) * a[1]; r[2] = bflo(gg[1]) * a[2]; r[3] = bfhi(gg[1]) * a[3];
                        float* mp = ma + (size_t)row * 1024 + c;
                        if (SECOND == 0) { *(f32x4*)mp = r; }
                        else { const f32x4 pv = *(const f32x4*)mp; r += pv; u32x2 w; w[0] = pk2(r[0], r[1]); w[1] = pk2(r[2], r[3]); *(u32x2*)(merged + (size_t)row * 1024 + c) = w; }
                    }
            }
    }
};
template <int FINAL> struct EpiRes {
    static constexpr bool PERM = false, AFTER_DRAIN = false;
    const float* xa; const float* xb; const float* mod; float* out;
    DI void operator()(const f32x4 (&acc)[2][2][4][2], const Unit& u, int wr, int wc, int fr, int fq) const {
        const int row0 = u.pm * 256 + wr * 64 + fr, col0 = u.pn * 256 + wc * 32 + 4 * fq;
        const int mi = u.pm < 16 ? 0 : 1 + ((u.pm - 16) >> 2);
        const float* gate = mod + mi * 6144 + (FINAL ? 5120 : 2048);
#pragma unroll
        for (int bj = 0; bj < 2; ++bj)
#pragma unroll
            for (int n = 0; n < 2; ++n) {
                const int c = col0 + bj * 128 + n * 16;
                const f32x4 gt = *(const f32x4*)(gate + c);
#pragma unroll
                for (int ai = 0; ai < 2; ++ai)
#pragma unroll
                    for (int m = 0; m < 4; ++m) {
                        const int row = row0 + ai * 128 + m * 16;
                        const float* xp = FINAL ? (out + (size_t)row * 1024 + c) : ((row < 4096 ? xa + (size_t)row * 1024 : xb + (size_t)(row - 4096) * 1024) + c);
                        const f32x4 xv = *(const f32x4*)xp;
                        *(f32x4*)(out + (size_t)row * 1024 + c) = xv + gt * acc[ai][bj][m][n];
                    }
            }
    }
};
struct EpiUp {
    static constexpr bool PERM = true, AFTER_DRAIN = false;
    bf16_t* act;
    DI void operator()(const f32x4 (&acc)[2][2][4][2], const Unit& u, int wr, int wc, int fr, int fq) const {
        const int row0 = u.pm * 256 + wr * 64 + fr, col = u.pn * 128 + wc * 32 + 8 * fq;
#pragma unroll
        for (int ai = 0; ai < 2; ++ai)
#pragma unroll
            for (int m = 0; m < 4; ++m) {
                const int row = row0 + ai * 128 + m * 16;
                float r[8];
#pragma unroll
                for (int n = 0; n < 2; ++n)
#pragma unroll
                    for (int j = 0; j < 4; ++j) r[n * 4 + j] = silu(acc[ai][0][m][n][j]) * acc[ai][1][m][n][j];
                u32x4 w; w[0] = pk2(r[0], r[1]); w[1] = pk2(r[2], r[3]); w[2] = pk2(r[4], r[5]); w[3] = pk2(r[6], r[7]);
                *(u32x4*)(act + (size_t)row * 2816 + col) = w;
            }
    }
};

DI void wconv_tile(const float* __restrict__ W, int N, bf16_t* __restrict__ Wt, int K, int n0dst, int n0src, int k0, unsigned char* lds, int tid) {
    bf16_t* T = (bf16_t*)lds;
    if (n0src >= 0) {
#pragma unroll
        for (int i = 0; i < 2; ++i) { const int idx = tid + NTHR * i, kr = idx >> 4, c4 = idx & 15;
            const f32x4 v = *(const f32x4*)(W + (size_t)(k0 + kr) * N + n0src + 4 * c4);
            u32x2 w; w[0] = pk2(v[0], v[1]); w[1] = pk2(v[2], v[3]); *(u32x2*)(T + kr * 68 + 4 * c4) = w; }
    }
    __syncthreads();
    { const int n = tid >> 3, kq = tid & 7; u32x4 w = {0u, 0u, 0u, 0u};
      if (n0src >= 0) {
#pragma unroll
          for (int j = 0; j < 4; ++j) { const unsigned lo = T[(kq * 8 + 2 * j) * 68 + n], hi = T[(kq * 8 + 2 * j + 1) * 68 + n]; w[j] = lo | (hi << 16); } }
      *(u32x4*)(Wt + (size_t)(n0dst + n) * K + k0 + kq * 8) = w; }
    __syncthreads();
}

DI void norm_rows(const float* xa, const float* xb, const float* __restrict__ g, const float* __restrict__ mod, int shift_off, int scale_off, bf16_t* __restrict__ dst, int gw, int nw, int lane) {
    for (int row = gw; row < TOK; row += nw) {
        const float* xr = row < 4096 ? xa + (size_t)row * 1024 : xb + (size_t)(row - 4096) * 1024;
        const float* mm = mod + (row < 4096 ? 0 : 1 + ((row - 4096) >> 10)) * 6144;
        f32x4 v[4]; float ss = 0.f;
#pragma unroll
        for (int i = 0; i < 4; ++i) { v[i] = *(const f32x4*)(xr + lane * 16 + i * 4); ss += v[i][0] * v[i][0] + v[i][1] * v[i][1] + v[i][2] * v[i][2] + v[i][3] * v[i][3]; }
        ss = wsum(ss);
        const float rstd = rsqrtf(ss * (1.0f / 1024.0f) + EPSF);
        u32x4 w[2];
#pragma unroll
        for (int i = 0; i < 4; ++i) { const int c = lane * 16 + i * 4;
            const f32x4 gg = *(const f32x4*)(g + c), sc = *(const f32x4*)(mm + scale_off + c), sh = *(const f32x4*)(mm + shift_off + c);
            f32x4 h;
#pragma unroll
            for (int j = 0; j < 4; ++j) h[j] = v[i][j] * rstd * gg[j] * (1.0f + sc[j]) + sh[j];
            w[i >> 1][(i & 1) * 2] = pk2(h[0], h[1]); w[i >> 1][(i & 1) * 2 + 1] = pk2(h[2], h[3]); }
        *(u32x4*)(dst + (size_t)row * 1024 + lane * 16) = w[0]; *(u32x4*)(dst + (size_t)row * 1024 + lane * 16 + 8) = w[1];
    }
}

DI void attn_pass(const bf16_t* __restrict__ qp, const bf16_t* __restrict__ kp, const bf16_t* __restrict__ vtp, int ldv, int nk, f32x16 (&o)[4], float& lsum, int lane) {
    const int r = lane & 31, hh = lane >> 5;
    bf16x8 qf[4];
#pragma unroll
    for (int ks = 0; ks < 4; ++ks) qf[ks] = *(const bf16x8*)(qp + r * 64 + ks * 16 + hh * 8);
#pragma unroll
    for (int i = 0; i < 4; ++i) o[i] = zero16();
    float l = 0.f;
#pragma unroll 1
    for (int kt = 0; kt < nk; kt += 32) {
        f32x16 s = zero16();
        const bf16_t* ka = kp + (size_t)(kt + r) * 64 + hh * 8;
#pragma unroll
        for (int ks = 0; ks < 4; ++ks) s = MFMA32(*(const bf16x8*)(ka + ks * 16), qf[ks], s);
#pragma unroll
        for (int i = 0; i < 16; ++i) { s[i] = __builtin_amdgcn_exp2f(s[i]); l += s[i]; }
        const bf16x8 p0 = pack8<0>(s), p1 = pack8<1>(s);
        const bf16_t* vb = vtp + (size_t)r * ldv + kt + 4 * hh;
#pragma unroll
        for (int vt = 0; vt < 4; ++vt) {
            const bf16_t* vv = vb + (size_t)vt * 32 * ldv;
            const bf16x8 v0 = cat4(*(const s16x4*)(vv), *(const s16x4*)(vv + 8)), v1 = cat4(*(const s16x4*)(vv + 16), *(const s16x4*)(vv + 24));
            o[vt] = MFMA32(v0, p0, o[vt]); o[vt] = MFMA32(v1, p1, o[vt]);
        }
    }
    lsum = l + __shfl_xor(l, 32);
}
DI void attn_item(const bf16_t* __restrict__ q0p, const bf16_t* __restrict__ q1p, const bf16_t* __restrict__ k0p, const bf16_t* __restrict__ k1p,
                  const bf16_t* __restrict__ vtp, int ldv, int nk, bf16_t* __restrict__ outp, float lam, const float* __restrict__ subg, int lane) {
    const int r = lane & 31, hh = lane >> 5;
    f32x16 o[4]; float l1, l0;
    attn_pass(q1p, k1p, vtp, ldv, nk, o, l1, lane);
    unsigned sv[4][8];
    { const float i1 = lam / l1;
#pragma unroll
      for (int vt = 0; vt < 4; ++vt)
#pragma unroll
          for (int j = 0; j < 8; ++j) sv[vt][j] = pk2(o[vt][2 * j] * i1, o[vt][2 * j + 1] * i1); }
    attn_pass(q0p, k0p, vtp, ldv, nk, o, l0, lane);
    const float i0 = 1.0f / l0;
    float ss = 0.f;
#pragma unroll
    for (int vt = 0; vt < 4; ++vt)
#pragma unroll
        for (int j = 0; j < 8; ++j) { const float t0 = o[vt][2 * j] * i0 - bflo(sv[vt][j]), t1 = o[vt][2 * j + 1] * i0 - bfhi(sv[vt][j]); o[vt][2 * j] = t0; o[vt][2 * j + 1] = t1; ss += t0 * t0 + t1 * t1; }
    ss += __shfl_xor(ss, 32);
    const float rs = rsqrtf(ss * (1.0f / 128.0f) + EPSF) * 0.8f;
    const float* sgp = subg; asm volatile("" : "+s"(sgp));
#pragma unroll
    for (int vt = 0; vt < 4; ++vt)
#pragma unroll
        for (int g4 = 0; g4 < 4; ++g4) { const int vd0 = vt * 32 + 8 * g4 + 4 * hh; const f32x4 sg = *(const f32x4*)(sgp + vd0);
            u32x2 w; w[0] = pk2(o[vt][4 * g4] * rs * sg[0], o[vt][4 * g4 + 1] * rs * sg[1]); w[1] = pk2(o[vt][4 * g4 + 2] * rs * sg[2], o[vt][4 * g4 + 3] * rs * sg[3]);
            *(u32x2*)(outp + (size_t)r * 1024 + vd0) = w; }
}

DI void store_yT1(const f32x16& y, float sc, bf16_t* __restrict__ yrow, int hh) {
#pragma unroll
    for (int g4 = 0; g4 < 4; ++g4) { u32x2 w; w[0] = pk2(y[4 * g4] * sc, y[4 * g4 + 1] * sc); w[1] = pk2(y[4 * g4 + 2] * sc, y[4 * g4 + 3] * sc); *(u32x2*)(yrow + 8 * g4 + 4 * hh) = w; }
}

DI void scan_item(int seq, int head, int dir, int pt, const bf16_t* __restrict__ XT, const bf16_t* __restrict__ BT, const bf16_t* __restrict__ CN,
                  const float* __restrict__ TE, const float* __restrict__ TW, const float* __restrict__ ATOT, const float* __restrict__ st_in, float* __restrict__ st_out,
                  bf16_t* __restrict__ Y, int lane) {
    const int r = lane & 31, hh = lane >> 5, g = head >> 2, col = dir * 32 + head;
    const int T0 = seq < 16 ? seq * 256 : 4096 + (seq - 16) * 1024, nc = seq < 16 ? 2 : 8;
    f32x16 H[4];
    if (seq < 16) {
#pragma unroll
        for (int nt = 0; nt < 4; ++nt) H[nt] = zero16();
    } else {
        const float* sp = st_in + ((size_t)((seq - 16) * 32 + head) * 64) * 128;
#pragma unroll
        for (int nt = 0; nt < 4; ++nt)
#pragma unroll
            for (int g4 = 0; g4 < 4; ++g4) { const f32x4 v = *(const f32x4*)(sp + (size_t)(pt * 32 + r) * 128 + nt * 32 + 8 * g4 + 4 * hh);
                H[nt][4 * g4] = v[0]; H[nt][4 * g4 + 1] = v[1]; H[nt][4 * g4 + 2] = v[2]; H[nt][4 * g4 + 3] = v[3]; }
    }
    const bf16_t* xrow = XT + (size_t)(head * 64 + pt * 32 + r) * 8192;
#pragma unroll 1
    for (int cc = 0; cc < nc; ++cc) {
        const int c = dir ? nc - 1 - cc : cc, t0 = T0 + c * 128;
        bf16x8 hp[4][2];
#pragma unroll
        for (int nt = 0; nt < 4; ++nt) { hp[nt][0] = pack8<0>(H[nt]); hp[nt][1] = pack8<1>(H[nt]); }
#pragma unroll 1
        for (int lt = 0; lt < 4; ++lt) {
            f32x16 y = zero16();
            const bf16_t* cp = CN + (size_t)(t0 + lt * 32 + r) * 1024 + g * 128 + 4 * hh;
#pragma unroll
            for (int nt = 0; nt < 4; ++nt) {
                const bf16x8 c0 = cat4(*(const s16x4*)(cp + nt * 32), *(const s16x4*)(cp + nt * 32 + 8)), c1 = cat4(*(const s16x4*)(cp + nt * 32 + 16), *(const s16x4*)(cp + nt * 32 + 24));
                y = MFMA32(hp[nt][0], c0, y); y = MFMA32(hp[nt][1], c1, y);
            }
            const float e = TE[(size_t)col * 8192 + t0 + lt * 32 + r];
            store_yT1(y, e, Y + (size_t)(t0 + lt * 32 + r) * 2048 + head * 64 + pt * 32, hh);
        }
        const float at = ATOT[(t0 >> 7) * 64 + col];
#pragma unroll
        for (int nt = 0; nt < 4; ++nt) H[nt] *= at;
#pragma unroll 2
        for (int ks = 0; ks < 8; ++ks) {
            const int so = t0 + ks * 16 + hh * 8;
            const f32x4 w0 = *(const f32x4*)(TW + (size_t)col * 8192 + so), w1 = *(const f32x4*)(TW + (size_t)col * 8192 + so + 4);
            const u32x4 xr = *(const u32x4*)(xrow + so);
            u32x4 xs; xs[0] = pk2(bflo(xr[0]) * w0[0], bfhi(xr[0]) * w0[1]); xs[1] = pk2(bflo(xr[1]) * w0[2], bfhi(xr[1]) * w0[3]);
            xs[2] = pk2(bflo(xr[2]) * w1[0], bfhi(xr[2]) * w1[1]); xs[3] = pk2(bflo(xr[3]) * w1[2], bfhi(xr[3]) * w1[3]);
            const bf16x8 xf = __builtin_bit_cast(bf16x8, xs);
#pragma unroll
            for (int nt = 0; nt < 4; ++nt) { const bf16x8 bf = *(const bf16x8*)(BT + (size_t)(g * 128 + nt * 32 + r) * 8192 + so); H[nt] = MFMA32(bf, xf, H[nt]); }
        }
    }
    if (seq < 16) {
        float* sp = st_out + ((size_t)(seq * 32 + head) * 64) * 128;
#pragma unroll
        for (int nt = 0; nt < 4; ++nt)
#pragma unroll
            for (int g4 = 0; g4 < 4; ++g4) { f32x4 v; v[0] = H[nt][4 * g4]; v[1] = H[nt][4 * g4 + 1]; v[2] = H[nt][4 * g4 + 2]; v[3] = H[nt][4 * g4 + 3];
                *(f32x4*)(sp + (size_t)(pt * 32 + r) * 128 + nt * 32 + 8 * g4 + 4 * hh) = v; }
    }
}

DI void diag_item(int sc, int head, int lt, const bf16_t* __restrict__ XT, const bf16_t* __restrict__ BN, const bf16_t* __restrict__ CN,
                  const float* __restrict__ CUM, const float* __restrict__ DTT, const float* __restrict__ Dskip, bf16_t* __restrict__ Y, int lane) {
    const int r = lane & 31, hh = lane >> 5, g = head >> 2, t0 = sc * 128, l = lt * 32 + r;
    bf16x8 cf[8];
#pragma unroll
    for (int ks = 0; ks < 8; ++ks) cf[ks] = *(const bf16x8*)(CN + (size_t)(t0 + l) * 1024 + g * 128 + ks * 16 + hh * 8);
    const float* cumf = CUM + (size_t)head * 8192 + t0; const float* cumb = CUM + (size_t)(32 + head) * 8192 + t0;
    const float* dtf = DTT + (size_t)head * 8192 + t0; const float* dtb = DTT + (size_t)(32 + head) * 8192 + t0;
    const float cfl = cumf[l], rbl = cumb[l], dsum = dtf[l] + dtb[l];
    f32x16 y0 = zero16(), y1 = zero16();
    for (int st = 0; st < 4; ++st) {
        f32x16 x = zero16();
#pragma unroll
        for (int ks = 0; ks < 8; ++ks) { const bf16x8 bf = *(const bf16x8*)(BN + (size_t)(t0 + st * 32 + r) * 1024 + g * 128 + ks * 16 + hh * 8); x = MFMA32(bf, cf[ks], x); }
#pragma unroll
        for (int g4 = 0; g4 < 4; ++g4) { const int s0 = st * 32 + 8 * g4 + 4 * hh;
            const f32x4 cfs = *(const f32x4*)(cumf + s0), dfs = *(const f32x4*)(dtf + s0), rbs = *(const f32x4*)(cumb + s0), dbs = *(const f32x4*)(dtb + s0);
#pragma unroll
            for (int j = 0; j < 4; ++j) { const int s = s0 + j;
                const float arg = s < l ? cfl - cfs[j] : rbl - rbs[j];
                const float e = __expf(fminf(arg, 0.f));
                const float val = s < l ? e * dfs[j] : (s > l ? e * dbs[j] : dsum);
                x[4 * g4 + j] *= val; } }
        const bf16x8 m0 = pack8<0>(x), m1 = pack8<1>(x);
#pragma unroll
        for (int pt = 0; pt < 2; ++pt) { const bf16_t* ap = XT + (size_t)(head * 64 + pt * 32 + r) * 8192 + t0 + st * 32 + 4 * hh;
            const bf16x8 a0 = cat4(*(const s16x4*)(ap), *(const s16x4*)(ap + 8)), a1 = cat4(*(const s16x4*)(ap + 16), *(const s16x4*)(ap + 24));
            if (pt == 0) { y0 = MFMA32(a0, m0, y0); y0 = MFMA32(a1, m1, y0); } else { y1 = MFMA32(a0, m0, y1); y1 = MFMA32(a1, m1, y1); } }
    }
    const float dsk = Dskip[head];
#pragma unroll
    for (int i = 0; i < 16; ++i) { const int p = (i & 3) + 8 * (i >> 2) + 4 * hh;
        y0[i] += dsk * __uint_as_float((unsigned)XT[(size_t)(head * 64 + p) * 8192 + t0 + l] << 16);
        y1[i] += dsk * __uint_as_float((unsigned)XT[(size_t)(head * 64 + 32 + p) * 8192 + t0 + l] << 16); }
    store_yT1(y0, 1.0f, Y + (size_t)(t0 + l) * 2048 + head * 64, hh); store_yT1(y1, 1.0f, Y + (size_t)(t0 + l) * 2048 + head * 64 + 32, hh);
}

__global__ void __launch_bounds__(NTHR, 2) mega(Params P) {
    extern __shared__ __attribute__((aligned(16))) unsigned char lds[];
    cg::grid_group grid = cg::this_grid();
    const int tid = threadIdx.x, lane = tid & 63, wv = __builtin_amdgcn_readfirstlane(tid >> 6);
    const int G = gridDim.x, bx = blockIdx.x, gw = bx * 8 + wv, nw = G * 8;
    unsigned char* ws = P.ws;
    float* MOD = (float*)(ws + WS_MOD); float* ATOT = (float*)(ws + WS_ATOT);
    float* out = P.out;
    PG8_LAS unsigned char* ldsg = (PG8_LAS unsigned char*)lds;

    if (PHMASK & (1u << 0))
    if (bx < 192) {
        float* s = (float*)lds;
        for (int i = tid; i < 5 * 1024; i += NTHR) { const int m = i >> 10, k = i & 1023; const float v = (m == 0) ? P.in[7][k] : P.in[2][(m - 1) * 1024 + k]; s[i] = silu(v); }
        __syncthreads();
        const int cl = tid & 31, kg = tid >> 5, col = bx * 32 + cl;
        float a[5] = {0.f, 0.f, 0.f, 0.f, 0.f};
        const float* wa = P.in[10];
        for (int i = 0; i < 64; ++i) { const int k = kg + 16 * i; const float w = wa[(size_t)k * 6144 + col];
#pragma unroll
            for (int m = 0; m < 5; ++m) a[m] += s[m * 1024 + k] * w; }
        float* red = s + 5120;
#pragma unroll
        for (int m = 0; m < 5; ++m) red[(kg * 5 + m) * 32 + cl] = a[m];
        __syncthreads();
        if (tid < 160) { const int m = tid >> 5; float t = 0.f; for (int q = 0; q < 16; ++q) t += red[(q * 5 + m) * 32 + cl]; MOD[m * 6144 + col] = t + P.in[11][col]; }
        __syncthreads();
    }
    {
        bf16_t* WIN = (bf16_t*)(ws + WS_WIN);
        for (int t = bx; t < 180 * 16; t += G) { const int nb = t >> 4, kb = t & 15, nd = nb * 64; int ns;
            if (nd < 3072) ns = nd; else if (nd < 5120) ns = 9280 + (nd - 3072); else if (nd < 5184) ns = 9216 + (nd - 5120); else if (nd < 5376) ns = -1; else ns = 3072 + (nd - 5376);
            wconv_tile(P.in[12], 11328, WIN, 1024, nd, ns, kb * 64, lds, tid); }
    }
    grid.sync();
    if (PHMASK & (1u << 1))
    norm_rows(P.in[0], P.in[1], P.in[8], MOD, 0, 1024, (bf16_t*)(ws + WS_HB), gw, nw, lane);
    grid.sync();
    if (PHMASK & (1u << 2))
    {
        pg8::Gemm g{(const bf16_t*)(ws + WS_HB), (const bf16_t*)(ws + WS_WIN), TOK, 5376, 1024}; pg8::StaticOrder S; S.init(TOK, 5376, G, bx);
        EpiIn1 E{(bf16_t*)(ws + WS_QK), (bf16_t*)(ws + WS_V), (bf16_t*)(ws + WS_G), (float*)(ws + WS_DT), out + 12582912};
        pg8::gemm_phase<EpiIn1, pg8::StaticOrder>(ldsg, g, S, E, nullptr);
    }
    grid.sync();
    if (PHMASK & (1u << 3))
    {
        const bf16_t* QK = (const bf16_t*)(ws + WS_QK);
        bf16_t* QN = (bf16_t*)(ws + WS_QN); bf16_t* KNI = (bf16_t*)(ws + WS_KNI); bf16_t* KNII = (bf16_t*)(ws + WS_KNII);
        float* nck = out + 8388608;
        for (int T = gw; T < TOK; T += nw) {
            const int pp = (T - 4096) & 1023, sub = lane & 3;
            const float pos = (float)((sub < 2) ? (pp >> 6) : (pp & 63)), sgn = (lane & 1) ? 1.0f : -1.0f;
#pragma unroll
            for (int qk = 0; qk < 2; ++qk) {
                const u32x4 r0 = *(const u32x4*)(QK + (size_t)T * 2048 + qk * 1024 + lane * 16), r1 = *(const u32x4*)(QK + (size_t)T * 2048 + qk * 1024 + lane * 16 + 8);
                float v[16];
#pragma unroll
                for (int j = 0; j < 4; ++j) { v[2 * j] = bflo(r0[j]); v[2 * j + 1] = bfhi(r0[j]); v[8 + 2 * j] = bflo(r1[j]); v[8 + 2 * j + 1] = bfhi(r1[j]); }
                float ss = 0.f;
#pragma unroll
                for (int e = 0; e < 16; ++e) ss += v[e] * v[e];
                ss += __shfl_xor(ss, 1); ss += __shfl_xor(ss, 2);
                const float rs = rsqrtf(ss * (1.0f / 64.0f) + EPSF);
                const float* gp = (qk ? P.in[14] : P.in[13]) + sub * 16;
#pragma unroll
                for (int e = 0; e < 16; ++e) v[e] = v[e] * rs * gp[e];
                if (qk == 1 && T < 4096) {
#pragma unroll
                    for (int i = 0; i < 4; ++i) { f32x4 o; o[0] = v[4 * i]; o[1] = v[4 * i + 1]; o[2] = v[4 * i + 2]; o[3] = v[4 * i + 3]; *(f32x4*)(nck + (size_t)T * 1024 + lane * 16 + 4 * i) = o; }
                }
                if (T >= 4096) {
#pragma unroll
                    for (int e = 0; e < 16; ++e) { const float pr = __shfl_xor(v[e], 1);
                        const float inv = __builtin_amdgcn_exp2f(-(float)e * (13.287712379549449f / 16.0f));
                        const float ang = pos * inv; const float sn = __sinf(ang), cs = __cosf(ang);
                        v[e] = v[e] * cs + sgn * pr * sn; }
                }
                if (qk == 0) {
#pragma unroll
                    for (int e = 0; e < 16; ++e) v[e] *= 0.125f * 1.4426950408889634f;
                }
                u32x4 w0, w1;
#pragma unroll
                for (int j = 0; j < 4; ++j) { w0[j] = pk2(v[2 * j], v[2 * j + 1]); w1[j] = pk2(v[8 + 2 * j], v[8 + 2 * j + 1]); }
                const int hd = lane >> 3, cc = (lane >> 2) & 1, d0 = sub * 16;
                bf16_t* dp;
                if (qk == 0) dp = QN + ((size_t)(hd * 2 + cc) * 8192 + T) * 64 + d0;
                else if (T < 4096) dp = KNI + ((size_t)(hd * 2 + cc) * 4096 + T) * 64 + d0;
                else dp = KNII + ((size_t)((((T - 4096) >> 10) * 8 + hd) * 2 + cc) * 1536 + pp) * 64 + d0;
                *(u32x4*)dp = w0; *(u32x4*)(dp + 8) = w1;
            }
        }
        for (int i = bx * NTHR + tid; i < 262144; i += G * NTHR) { const int e = i * 8, d = e & 63, cc = (e >> 6) & 1, hd = (e >> 7) & 7, pq = (e >> 10) & 511, b = e >> 19;
            const f32x4 a = *(const f32x4*)(P.in[3] + e), c = *(const f32x4*)(P.in[3] + e + 4);
            u32x4 w; w[0] = pk2(a[0], a[1]); w[1] = pk2(a[2], a[3]); w[2] = pk2(c[0], c[1]); w[3] = pk2(c[2], c[3]);
            *(u32x4*)(KNII + ((size_t)((b * 8 + hd) * 2 + cc) * 1536 + 1024 + pq) * 64 + d) = w; }
        { float* CUM = (float*)(ws + WS_TAB); float* DTT = CUM + TABSZ; float* TE = DTT + TABSZ; float* TW = TE + TABSZ; const float* DT = (const float*)(ws + WS_DT);
          for (int it = gw; it < 4096; it += nw) { const int sc = it >> 6, col = it & 63;
            const float bias = P.in[23][col], A = -__expf(P.in[22][col]);
            const float x0 = DT[(size_t)(sc * 128 + 2 * lane) * 64 + col] + bias, x1 = DT[(size_t)(sc * 128 + 2 * lane + 1) * 64 + col] + bias;
            const float d0 = x0 > 20.f ? x0 : log1pf(__expf(x0)), d1 = x1 > 20.f ? x1 : log1pf(__expf(x1));
            const float a0 = d0 * A, a1 = d1 * A;
            float x = a0 + a1;
#pragma unroll
            for (int o = 1; o < 64; o <<= 1) { const float t = __shfl_up(x, o); if (lane >= o) x += t; }
            const float tot = __shfl(x, 63);
            float c1 = x, c0 = x - a1;
            if (col >= 32) { c0 = tot - c0 + a0; c1 = tot - c1 + a1; }
            const size_t o = (size_t)col * 8192 + sc * 128 + 2 * lane;
            *(f32x2*)(CUM + o) = (f32x2){c0, c1}; *(f32x2*)(DTT + o) = (f32x2){d0, d1};
            *(f32x2*)(TE + o) = (f32x2){__expf(c0), __expf(c1)}; *(f32x2*)(TW + o) = (f32x2){d0 * __expf(tot - c0), d1 * __expf(tot - c1)};
            if (lane == 0) ATOT[sc * 64 + col] = __expf(tot); } }
        { const bf16_t* V = (const bf16_t*)(ws + WS_V); bf16_t* VTI = (bf16_t*)(ws + WS_VTI); bf16_t* VTII = (bf16_t*)(ws + WS_VTII); bf16_t* Ls = (bf16_t*)lds;
          for (int u = bx; u < 1280; u += G) {
            bf16_t* dst; size_t ldd;
            if (u < 1024) { const int tb = u >> 3, hd = u & 7, T0 = tb * 64;
#pragma unroll
                for (int i = 0; i < 2; ++i) { const int idx = tid + NTHR * i, rr = idx >> 4, c8 = idx & 15; *(u32x4*)(Ls + rr * 136 + c8 * 8) = *(const u32x4*)(V + (size_t)(T0 + rr) * 1024 + hd * 128 + c8 * 8); }
                if (T0 < 4096) { dst = VTI + (size_t)hd * 128 * 4096 + T0; ldd = 4096; } else { const int b = (T0 - 4096) >> 10, p0 = (T0 - 4096) & 1023; dst = VTII + (size_t)(b * 8 + hd) * 128 * 1536 + p0; ldd = 1536; }
            } else { const int uu = u - 1024, b = uu >> 6, pb = (uu >> 3) & 7, hd = uu & 7;
#pragma unroll
                for (int i = 0; i < 4; ++i) { const int idx = tid + NTHR * i, rr = idx >> 5, c4 = idx & 31;
                    const f32x4 a = *(const f32x4*)(P.in[4] + ((size_t)((b * 512 + pb * 64 + rr) * 8 + hd)) * 128 + c4 * 4);
                    u32x2 w; w[0] = pk2(a[0], a[1]); w[1] = pk2(a[2], a[3]); *(u32x2*)(Ls + rr * 136 + c4 * 4) = w; }
                dst = VTII + (size_t)(b * 8 + hd) * 128 * 1536 + 1024 + pb * 64; ldd = 1536; }
            __syncthreads();
            { const int vd = tid >> 2, tq = tid & 3; u32x4 w0, w1;
#pragma unroll
              for (int j = 0; j < 4; ++j) { w0[j] = (unsigned)Ls[(tq * 16 + 2 * j) * 136 + vd] | ((unsigned)Ls[(tq * 16 + 2 * j + 1) * 136 + vd] << 16);
                                            w1[j] = (unsigned)Ls[(tq * 16 + 8 + 2 * j) * 136 + vd] | ((unsigned)Ls[(tq * 16 + 8 + 2 * j + 1) * 136 + vd] << 16); }
              bf16_t* dp = dst + (size_t)vd * ldd + tq * 16; *(u32x4*)dp = w0; *(u32x4*)(dp + 8) = w1; }
            __syncthreads();
          } }
    }
    grid.sync();
    if (PHMASK & (1u << 4))
    {
        const bf16_t* QN = (const bf16_t*)(ws + WS_QN); const bf16_t* KNI = (const bf16_t*)(ws + WS_KNI); const bf16_t* KNII = (const bf16_t*)(ws + WS_KNII);
        const bf16_t* VTI = (const bf16_t*)(ws + WS_VTI); const bf16_t* VTII = (const bf16_t*)(ws + WS_VTII); bf16_t* OATT = (bf16_t*)(ws + WS_OATT);
        const float lam = __expf(wsum(P.in[15][lane] * P.in[16][lane])) - __expf(wsum(P.in[17][lane] * P.in[18][lane])) + 0.2f;
        if (wv < 4) {
            for (int id = bx * 4 + wv; id < 1024; id += G * 4) { const int b = id >> 8, hd = (id >> 5) & 7, qt = id & 31, tok0 = 4096 + b * 1024 + qt * 32;
                attn_item(QN + ((size_t)(hd * 2) * 8192 + tok0) * 64, QN + ((size_t)(hd * 2 + 1) * 8192 + tok0) * 64,
                          KNII + (size_t)((b * 8 + hd) * 2) * 1536 * 64, KNII + (size_t)((b * 8 + hd) * 2 + 1) * 1536 * 64,
                          VTII + (size_t)(b * 8 + hd) * 128 * 1536, 1536, 1536, OATT + (size_t)tok0 * 1024 + hd * 128, lam, P.in[19], lane); }
        } else {
            for (int id = bx * 4 + (wv - 4); id < 1024; id += G * 4) { const int b = id >> 6, hd = (id >> 3) & 7, qt = id & 7, tok0 = b * 256 + qt * 32;
                attn_item(QN + ((size_t)(hd * 2) * 8192 + tok0) * 64, QN + ((size_t)(hd * 2 + 1) * 8192 + tok0) * 64,
                          KNI + ((size_t)(hd * 2) * 4096 + b * 256) * 64, KNI + ((size_t)(hd * 2 + 1) * 4096 + b * 256) * 64,
                          VTI + (size_t)hd * 128 * 4096 + b * 256, 4096, 256, OATT + (size_t)tok0 * 1024 + hd * 128, lam, P.in[19], lane); }
        }
    }
    grid.sync();
    if (PHMASK & (1u << 5))
    {
        pg8::Gemm g{(const bf16_t*)(ws + WS_HB), (const bf16_t*)(ws + WS_WIN) + (size_t)5376 * 1024, TOK, 6144, 1024}; pg8::StaticOrder S; S.init(TOK, 6144, G, bx);
        EpiIn2 E{(bf16_t*)(ws + WS_Z), (bf16_t*)(ws + WS_XBC)};
        pg8::gemm_phase<EpiIn2, pg8::StaticOrder>(ldsg, g, S, E, nullptr);
    }
    grid.sync();
    if (PHMASK & (1u << 6))
    {
        const bf16_t* XBC = (const bf16_t*)(ws + WS_XBC); bf16_t* XT = (bf16_t*)out; bf16_t* BT = (bf16_t*)(ws + WS_BT); bf16_t* BN = (bf16_t*)(ws + WS_BN); bf16_t* CN = (bf16_t*)(ws + WS_CN);
        bf16_t* Li = (bf16_t*)lds;
        bf16_t* Lo = Li + 68 * 136;
        for (int u = bx; u < 4096; u += G) { const int tb = u >> 5, cb = u & 31, T0 = tb * 64, ch0 = cb * 128;
            const int s0 = T0 < 4096 ? (T0 & ~255) : 4096 + ((T0 - 4096) & ~1023), s1 = s0 + (T0 < 4096 ? 256 : 1024);
            for (int idx = tid; idx < 68 * 16; idx += NTHR) { const int rr = idx >> 4, c8 = idx & 15, T = T0 - 2 + rr; u32x4 w = {0u, 0u, 0u, 0u};
                if (T >= s0 && T < s1) w = *(const u32x4*)(XBC + (size_t)T * 4096 + ch0 + c8 * 8);
                *(u32x4*)(Li + rr * 136 + c8 * 8) = w; }
            __syncthreads();
            { const int ch = tid & 127, tg = tid >> 7; const float* cw = P.in[20] + ch0 + ch; const float bias = P.in[21][ch0 + ch];
              const float w0 = cw[0], w1 = cw[4096], w2 = cw[2 * 4096], w3 = cw[3 * 4096], w4 = cw[4 * 4096];
              float x0 = __uint_as_float((unsigned)Li[(tg * 16 + 0) * 136 + ch] << 16), x1 = __uint_as_float((unsigned)Li[(tg * 16 + 1) * 136 + ch] << 16),
                    x2 = __uint_as_float((unsigned)Li[(tg * 16 + 2) * 136 + ch] << 16), x3 = __uint_as_float((unsigned)Li[(tg * 16 + 3) * 136 + ch] << 16);
#pragma unroll
              for (int j = 0; j < 16; ++j) { const float x4 = __uint_as_float((unsigned)Li[(tg * 16 + j + 4) * 136 + ch] << 16);
                  const float y = bias + w0 * x0 + w1 * x1 + w2 * x2 + w3 * x3 + w4 * x4;
                  Lo[(tg * 16 + j) * 136 + ch] = (bf16_t)(pk2(silu(y), 0.f) & 0xffffu);
                  x0 = x1; x1 = x2; x2 = x3; x3 = x4; } }
            __syncthreads();
            if (cb < 24) {
                bf16_t* dst = cb < 16 ? XT + (size_t)ch0 * 8192 + T0 : BT + (size_t)(ch0 - 2048) * 8192 + T0;
                const int ch = tid >> 2, tq = tid & 3; u32x4 a0, a1;
#pragma unroll
                for (int j = 0; j < 4; ++j) { a0[j] = (unsigned)Lo[(tq * 16 + 2 * j) * 136 + ch] | ((unsigned)Lo[(tq * 16 + 2 * j + 1) * 136 + ch] << 16);
                                              a1[j] = (unsigned)Lo[(tq * 16 + 8 + 2 * j) * 136 + ch] | ((unsigned)Lo[(tq * 16 + 8 + 2 * j + 1) * 136 + ch] << 16); }
                bf16_t* dp = dst + (size_t)ch * 8192 + tq * 16; *(u32x4*)dp = a0; *(u32x4*)(dp + 8) = a1;
            }
            if (cb >= 16) {
                bf16_t* dst = cb < 24 ? BN + (ch0 - 2048) : CN + (ch0 - 3072);
#pragma unroll
                for (int i = 0; i < 2; ++i) { const int idx = tid + NTHR * i, rr = idx >> 4, c8 = idx & 15; *(u32x4*)(dst + (size_t)(T0 + rr) * 1024 + c8 * 8) = *(const u32x4*)(Lo + rr * 136 + c8 * 8); }
            }
            __syncthreads();
        }
    }
    grid.sync();
    if (PHMASK & (1u << 7))
    {
        const bf16_t* XT = (const bf16_t*)out; const bf16_t* BT = (const bf16_t*)(ws + WS_BT); const bf16_t* BN = (const bf16_t*)(ws + WS_BN); const bf16_t* CN = (const bf16_t*)(ws + WS_CN);
        const float* CUM = (const float*)(ws + WS_TAB); const float* DTT = CUM + TABSZ; const float* TE = DTT + TABSZ; const float* TW = TE + TABSZ;
        bf16_t* YD = (bf16_t*)(ws + WS_YD); bf16_t* YF = (bf16_t*)(ws + WS_YF); bf16_t* YB = (bf16_t*)(ws + WS_YB);
        int* qcnt = (int*)(lds + 131072);
        if (tid == 0) *qcnt = 0;
        __syncthreads();
        if (wv < 2) {
            for (int id = bx * 2 + wv; id < 512; id += G * 2) { const int seq = 16 + (id >> 7), head = (id >> 2) & 31, dir = (id >> 1) & 1, pt = id & 1;
                scan_item(seq, head, dir, pt, XT, BT, CN, TE, TW, ATOT, dir ? P.in[6] : P.in[5], out + (dir ? 20971520 : 16777216), dir ? YB : YF, lane); }
        } else {
            const int k0 = wv < 4 ? (wv - 2) * 2 : wv, nk = wv < 4 ? 2 : 1;
            for (int kk = k0; kk < k0 + nk; ++kk)
                for (int id = bx * 8 + kk; id < 2048; id += G * 8) { const int seq = id >> 7, head = (id >> 2) & 31, dir = (id >> 1) & 1, pt = id & 1;
                    scan_item(seq, head, dir, pt, XT, BT, CN, TE, TW, ATOT, dir ? P.in[6] : P.in[5], out + (dir ? 20971520 : 16777216), dir ? YB : YF, lane); }
        }
        for (int vb = bx; vb < 256; vb += G) {
            for (;;) { int k = 0; if (lane == 0) k = atomicAdd(qcnt, 1); k = __builtin_amdgcn_readfirstlane(k); if (k >= 32) break;
                const int pair = vb * 2 + (k >> 4), sc = pair >> 3, g = pair & 7, head = g * 4 + ((k >> 2) & 3), lt = k & 3;
                diag_item(sc, head, lt, XT, BN, CN, CUM, DTT, P.in[24], YD, lane); }
        }
    }
    grid.sync();
    if (PHMASK & (1u << 8))
    {
        const bf16_t* YD = (const bf16_t*)(ws + WS_YD); const bf16_t* YF = (const bf16_t*)(ws + WS_YF); const bf16_t* YB = (const bf16_t*)(ws + WS_YB); const bf16_t* Z = (const bf16_t*)(ws + WS_Z);
        bf16_t* YG = (bf16_t*)(ws + WS_YG);
        for (int row = gw; row < TOK; row += nw) {
            float u[32]; float ss = 0.f;
#pragma unroll
            for (int i = 0; i < 4; ++i) { const size_t o = (size_t)row * 2048 + lane * 32 + i * 8;
                const u32x4 a = *(const u32x4*)(YD + o), b = *(const u32x4*)(YF + o), c = *(const u32x4*)(YB + o), z = *(const u32x4*)(Z + o);
#pragma unroll
                for (int j = 0; j < 4; ++j) { const float y0 = bflo(a[j]) + bflo(b[j]) + bflo(c[j]), y1 = bfhi(a[j]) + bfhi(b[j]) + bfhi(c[j]);
                    const float t0 = y0 * silu(bflo(z[j])), t1 = y1 * silu(bfhi(z[j])); u[i * 8 + 2 * j] = t0; u[i * 8 + 2 * j + 1] = t1; ss += t0 * t0 + t1 * t1; } }
            ss = wsum(ss);
            const float rstd = rsqrtf(ss * (1.0f / 2048.0f) + EPSF);
#pragma unroll
            for (int i = 0; i < 4; ++i) { const int c = lane * 32 + i * 8; const f32x4 g0 = *(const f32x4*)(P.in[25] + c), g1 = *(const f32x4*)(P.in[25] + c + 4);
                u32x4 w; w[0] = pk2(u[i * 8] * rstd * g0[0], u[i * 8 + 1] * rstd * g0[1]); w[1] = pk2(u[i * 8 + 2] * rstd * g0[2], u[i * 8 + 3] * rstd * g0[3]);
                w[2] = pk2(u[i * 8 + 4] * rstd * g1[0], u[i * 8 + 5] * rstd * g1[1]); w[3] = pk2(u[i * 8 + 6] * rstd * g1[2], u[i * 8 + 7] * rstd * g1[3]);
                *(u32x4*)(YG + (size_t)row * 2048 + c) = w; }
        }
        for (int t = bx; t < 3136; t += G) {
            if (t < 256) wconv_tile(P.in[26], 1024, (bf16_t*)(ws + WS_WA), 1024, (t >> 4) * 64, (t >> 4) * 64, (t & 15) * 64, lds, tid);
            else if (t < 768) { const int q = t - 256; wconv_tile(P.in[27], 1024, (bf16_t*)(ws + WS_WB), 2048, (q >> 5) * 64, (q >> 5) * 64, (q & 31) * 64, lds, tid); }
            else if (t < 1024) { const int q = t - 768; wconv_tile(P.in[28], 1024, (bf16_t*)(ws + WS_WOUT), 1024, (q >> 4) * 64, (q >> 4) * 64, (q & 15) * 64, lds, tid); }
            else if (t < 2432) { const int q = t - 1024, nb = q >> 4, kb = q & 15, pn = nb >> 2, qq = nb & 3;
                wconv_tile(qq < 2 ? P.in[29] : P.in[30], 2816, (bf16_t*)(ws + WS_WGU), 1024, nb * 64, pn * 128 + (qq & 1) * 64, kb * 64, lds, tid); }
            else { const int q = t - 2432, nb = q / 44, kb = q % 44; wconv_tile(P.in[31], 1024, (bf16_t*)(ws + WS_WD), 2816, nb * 64, nb * 64, kb * 64, lds, tid); }
        }
    }
    grid.sync();
    if (PHMASK & (1u << 9))
    {
        pg8::StaticOrder S; S.init(TOK, 1024, G, bx);
        { pg8::Gemm g{(const bf16_t*)(ws + WS_OATT), (const bf16_t*)(ws + WS_WA), TOK, 1024, 1024};
          EpiBranch<0> E{(const bf16_t*)(ws + WS_G), (float*)(ws + WS_MA), (bf16_t*)(ws + WS_MERGED)};
          pg8::gemm_phase<EpiBranch<0>, pg8::StaticOrder>(ldsg, g, S, E, nullptr); }
        __syncthreads();
        { pg8::Gemm g{(const bf16_t*)(ws + WS_YG), (const bf16_t*)(ws + WS_WB), TOK, 1024, 2048};
          EpiBranch<1> E{(const bf16_t*)(ws + WS_G), (float*)(ws + WS_MA), (bf16_t*)(ws + WS_MERGED)};
          pg8::gemm_phase<EpiBranch<1>, pg8::StaticOrder>(ldsg, g, S, E, nullptr); }
    }
    grid.sync();
    if (PHMASK & (1u << 10))
    {
        pg8::Gemm g{(const bf16_t*)(ws + WS_MERGED), (const bf16_t*)(ws + WS_WOUT), TOK, 1024, 1024}; pg8::StaticOrder S; S.init(TOK, 1024, G, bx);
        EpiRes<0> E{P.in[0], P.in[1], MOD, out};
        pg8::gemm_phase<EpiRes<0>, pg8::StaticOrder>(ldsg, g, S, E, nullptr);
    }
    grid.sync();
    if (PHMASK & (1u << 11))
    norm_rows(out, out + (size_t)4096 * 1024, P.in[9], MOD, 3072, 4096, (bf16_t*)(ws + WS_H2), gw, nw, lane);
    grid.sync();
    if (PHMASK & (1u << 12))
    {
        pg8::Gemm g{(const bf16_t*)(ws + WS_H2), (const bf16_t*)(ws + WS_WGU), TOK, 5632, 1024}; pg8::StaticOrder S; S.init(TOK, 5632, G, bx);
        EpiUp E{(bf16_t*)(ws + WS_ACT)};
        pg8::gemm_phase<EpiUp, pg8::StaticOrder>(ldsg, g, S, E, nullptr);
    }
    grid.sync();
    if (PHMASK & (1u << 13))
    {
        pg8::Gemm g{(const bf16_t*)(ws + WS_ACT), (const bf16_t*)(ws + WS_WD), TOK, 1024, 2816}; pg8::StaticOrder S; S.init(TOK, 1024, G, bx);
        EpiRes<1> E{P.in[0], P.in[1], MOD, out};
        pg8::gemm_phase<EpiRes<1>, pg8::StaticOrder>(ldsg, g, S, E, nullptr);
    }
}

extern "C" void kernel_launch(void* const* d_in, const int* in_sizes, int n_in, void* d_out, int out_size, void* d_ws, size_t ws_size, hipStream_t stream) {
    static int grid = 0;
    if (grid == 0) {
        int dev = 0, cus = 0, per_cu = 0;
        (void)hipGetDevice(&dev);
        (void)hipDeviceGetAttribute(&cus, hipDeviceAttributeMultiprocessorCount, dev);
        if (hipFuncSetAttribute((const void*)mega, hipFuncAttributeMaxDynamicSharedMemorySize, LDS_BYTES) != hipSuccess) fprintf(stderr, "kernel_launch: hipFuncSetAttribute failed\n");
        if (hipOccupancyMaxActiveBlocksPerMultiprocessor(&per_cu, (const void*)mega, NTHR, LDS_BYTES) != hipSuccess || per_cu < 1) { fprintf(stderr, "kernel_launch: occupancy query says %d blocks/CU\n", per_cu); per_cu = 1; }
        (void)hipGetLastError();
        grid = cus > 256 ? 256 : cus;
        if (ws_size < 256 * MiB) fprintf(stderr, "kernel_launch: workspace too small: %zu\n", ws_size);
    }
    Params p{};
    for (int i = 0; i < 32; ++i) p.in[i] = (const float*)d_in[i];
    p.out = (float*)d_out; p.ws = (unsigned char*)d_ws;
    void* args[] = {&p};
    hipError_t e = hipLaunchCooperativeKernel((const void*)mega, dim3(grid), dim3(NTHR), args, LDS_BYTES, stream);
    if (e != hipSuccess) fprintf(stderr, "kernel_launch: cooperative launch failed: %s (grid %d)\n", hipGetErrorString(e), grid);
}
```

```cpp
#include <hip/hip_runtime.h>
#include <hip/hip_cooperative_groups.h>
#include <cstdio>
namespace cg = cooperative_groups;

#define DI __device__ __forceinline__
typedef unsigned short bf16_t;
typedef short bf16x8 __attribute__((ext_vector_type(8)));
typedef short s16x4 __attribute__((ext_vector_type(4)));
typedef float f32x4 __attribute__((ext_vector_type(4)));
typedef float f32x2 __attribute__((ext_vector_type(2)));
typedef float f32x16 __attribute__((ext_vector_type(16)));
typedef unsigned u32x4 __attribute__((ext_vector_type(4)));
typedef unsigned u32x2 __attribute__((ext_vector_type(2)));
typedef __bf16 bf16v2 __attribute__((ext_vector_type(2)));

DI unsigned pk2(float a, float b) { f32x2 v = {a, b}; bf16v2 r = __builtin_convertvector(v, bf16v2); return __builtin_bit_cast(unsigned, r); }
DI float bflo(unsigned u) { return __uint_as_float(u << 16); }
DI float bfhi(unsigned u) { return __uint_as_float(u & 0xffff0000u); }
DI float sigm(float x) { return __builtin_amdgcn_rcpf(1.0f + __builtin_amdgcn_exp2f(-1.4426950408889634f * x)); }
DI float silu(float x) { return x * sigm(x); }
#define MFMA32(a, b, c) __builtin_amdgcn_mfma_f32_32x32x16_bf16((a), (b), (c), 0, 0, 0)
DI f32x16 zero16() { f32x16 z; _Pragma("unroll") for (int i = 0; i < 16; ++i) z[i] = 0.f; return z; }
template <int S> DI bf16x8 pack8(const f32x16& x) {
    u32x4 p; p[0] = pk2(x[8 * S], x[8 * S + 1]); p[1] = pk2(x[8 * S + 2], x[8 * S + 3]); p[2] = pk2(x[8 * S + 4], x[8 * S + 5]); p[3] = pk2(x[8 * S + 6], x[8 * S + 7]);
    return __builtin_bit_cast(bf16x8, p);
}
DI bf16x8 cat4(s16x4 a, s16x4 b) { return __builtin_shufflevector(a, b, 0, 1, 2, 3, 4, 5, 6, 7); }
DI float shx(float v, int mask) { int ln = (int)__lane_id(); asm volatile("" : "+v"(ln)); return __uint_as_float((unsigned)__builtin_amdgcn_ds_bpermute((ln ^ mask) << 2, (int)__float_as_uint(v))); }
DI float wsum(float v) { int ln = (int)__lane_id(); asm volatile("" : "+v"(ln)); _Pragma("unroll") for (int o = 32; o >= 1; o >>= 1) v += __uint_as_float((unsigned)__builtin_amdgcn_ds_bpermute((ln ^ o) << 2, (int)__float_as_uint(v))); return v; }

#define XB_TMO      128
#define XB_XCNT(j)  (256  + 64 * (j))
#define XB_XSUB(j)  (1280 + 64 * (j))
#define XB_XGEN(j)  (2304 + 64 * (j))
#define XB_TOP      3328
#define XB_TOPGEN   3392
#define XCD_BAR_WORDS 3456
#define XB_SPIN_CAP (1u << 18)
#define LAS __attribute__((address_space(3)))

__device__ __forceinline__ unsigned xb_ld(unsigned* p)              { return __hip_atomic_load(p, __ATOMIC_RELAXED, __HIP_MEMORY_SCOPE_AGENT); }
__device__ __forceinline__ unsigned xb_add(unsigned* p, unsigned v) { return __hip_atomic_fetch_add(p, v, __ATOMIC_RELAXED, __HIP_MEMORY_SCOPE_AGENT); }
__device__ __forceinline__ unsigned xb_xcc_id() { return (unsigned)__builtin_amdgcn_s_getreg((3 << 11) | 20) & 0xFu; }
#define XB_SPIN(cond, bar) do { unsigned _sp = 0; while (cond) { __builtin_amdgcn_s_sleep(1); \
    if ((++_sp & 255u) == 0u) { if (xb_ld(&(bar)[XB_TMO])) break; if (_sp > XB_SPIN_CAP) { atomicAdd(&(bar)[XB_TMO], 1u); break; } } } } while (0)

struct XcdBarrier {
    unsigned* bar; unsigned x;
    volatile LAS unsigned* st;
};

__device__ __forceinline__ XcdBarrier xcd_barrier_post(unsigned* bar, volatile LAS unsigned* st) {
    XcdBarrier b; b.bar = bar; b.x = xb_xcc_id(); b.st = st;
    if (threadIdx.x == 0) (void)xb_add(&bar[XB_XCNT(b.x)], 1u);
    return b;
}
__device__ __forceinline__ void xcd_barrier_complete(unsigned* bar, unsigned x, unsigned& nloc, unsigned& nx) {
    const unsigned G = gridDim.x * gridDim.y * gridDim.z;
    unsigned sum, cnt, mine, sp = 0u;
    for (;;) {
        sum = 0u; cnt = 0u; mine = 0u;
#pragma unroll
        for (unsigned j = 0; j < 16; ++j) { const unsigned c = xb_ld(&bar[XB_XCNT(j)]); sum += c; cnt += (c > 0u) ? 1u : 0u; mine = (j == x) ? c : mine; }
        if (sum == G) break;
        __builtin_amdgcn_s_sleep(1);
        if ((++sp & 255u) == 0u) { if (xb_ld(&bar[XB_TMO])) break; if (sp > XB_SPIN_CAP) { atomicAdd(&bar[XB_TMO], 1u); break; } }
    }
    nloc = mine > 0u ? mine : 1u; nx = cnt > 0u ? cnt : 1u;
}

__device__ __forceinline__ void xcd_barrier(const XcdBarrier& b) {
    asm volatile("s_waitcnt vmcnt(0)" ::: "memory");
    __syncthreads();
    if (threadIdx.x == 0) {
        unsigned* bar = b.bar;
        __builtin_amdgcn_s_waitcnt(0);
        unsigned nloc = b.st[0], nx = b.st[1];
        if (nloc == 0u) { xcd_barrier_complete(bar, b.x, nloc, nx); b.st[0] = nloc; b.st[1] = nx; }
        const unsigned old = xb_add(&bar[XB_XSUB(b.x)], 1u);
        const unsigned gen = old / nloc;
        if (old + 1u == (gen + 1u) * nloc) {
            __builtin_amdgcn_fence(__ATOMIC_RELEASE, "agent");
            asm volatile("s_waitcnt vmcnt(0)" ::: "memory");
            const unsigned og = xb_add(&bar[XB_TOP], 1u);
            const unsigned tg = og / nx;
            if (og + 1u == (tg + 1u) * nx) xb_add(&bar[XB_TOPGEN], 1u);
            else XB_SPIN(xb_ld(&bar[XB_TOPGEN]) == tg, bar);
            __builtin_amdgcn_fence(__ATOMIC_ACQUIRE, "agent");
            xb_add(&bar[XB_XGEN(b.x)], 1u);
            asm volatile("s_waitcnt vmcnt(0)" ::: "memory");
        } else {
            XB_SPIN(xb_ld(&bar[XB_XGEN(b.x)]) == gen, bar);
            __builtin_amdgcn_fence(__ATOMIC_ACQUIRE, "agent");
            asm volatile("s_waitcnt vmcnt(0)" ::: "memory");
        }
    }
    __syncthreads();
}

namespace pg8 {
#define PG8_LAS __attribute__((address_space(3)))
typedef unsigned short bf16_t;
typedef short bf16x8 __attribute__((ext_vector_type(8)));
typedef float f32x4 __attribute__((ext_vector_type(4)));
typedef unsigned u32x4 __attribute__((ext_vector_type(4)));
constexpr int BM = 256, BK = 64, HALF = 128, HTB = HALF * BK * 2  , STAGE_BYTES = 8 * HTB, NXCD = 8, WGM = 8;

__host__ __device__ __forceinline__ int lds_byte(int r, int c) { const int st = (r >> 4) * 2 + (c >> 5), rr = r & 15, cc = c & 31, ob = rr * 64 + cc * 2; return st * 1024 + (ob ^ (((ob >> 9) & 1) << 5)); }
__host__ __device__ __forceinline__ void stage_rc(int b, int& R, int& C) { const int st = b / 1024, sb = b % 1024, swz = sb ^ (((sb >> 9) & 1) << 5); R = (st >> 1) * 16 + swz / 64; C = (st & 1) * 32 + (swz % 64) / 2; }
__host__ __device__ __forceinline__ int perm32(int rho) { const int n = rho >> 4, i = rho & 15; return 8 * (i >> 2) + 4 * n + (i & 3); }

struct Unit { int pm, pn; };
struct Gemm { const bf16_t* A; const bf16_t* Bt; int M, N, K; };

struct StaticOrder {
    int nM, nN, nwg, G, c;
    __host__ __device__ void init(int M, int N, int G_, int c_) { nM = M / BM; nN = N / BM; nwg = nM * nN; G = G_; c = c_; }
    __host__ __device__ bool next(int i, Unit& u) const {
        const long L = (long)i * G + c; if (L >= nwg) return false;
        int wgid = (int)L; { const int q = nwg / NXCD, r = nwg % NXCD, xcd = wgid % NXCD, off = wgid / NXCD; wgid = (xcd < r ? xcd * (q + 1) : r * (q + 1) + (xcd - r) * q) + off; }
        const int nig = WGM * nN, gid = wgid / nig, fm = gid * WGM, gsz = (nM - fm) < WGM ? (nM - fm) : WGM;
        u.pm = fm + ((wgid % nig) % gsz); u.pn = (wgid % nig) / gsz; return true;
    }
    __device__ __forceinline__ void a_ready(const Unit&) const {}
    __device__ __forceinline__ void done(const Unit&) const {}
};
template <class Epi, class Sched, bool STAMP = false, bool HALFM = false>
__device__ __forceinline__ void gemm_phase(PG8_LAS unsigned char* lds, const Gemm g, const Sched& S, const Epi& E, unsigned long long* stamps) {
    int tid_l = threadIdx.x; asm volatile("" : "+v"(tid_l));
    const int tid = tid_l, wid = __builtin_amdgcn_readfirstlane(tid >> 6), lane = tid & 63, wr = wid >> 2, wc = wid & 3, fr = lane & 15, fq = lane >> 4;
    const int K = g.K, nt = K / BK;
    int ts_lo = 0, ts_hi = 0, nts = 0; const unsigned long long rt_entry = STAMP ? (unsigned long long)wall_clock64() : 0ull;
#define PG8_STAMP() do { if (STAMP && wid == 0 && nts < 64) { const unsigned long long _c = (unsigned long long)clock64(); \
        ts_lo = (lane == nts) ? (int)(unsigned)_c : ts_lo; ts_hi = (lane == nts) ? (int)(unsigned)(_c >> 32) : ts_hi; ++nts; } } while (0)
    PG8_STAMP();
    unsigned voffA[2], voffB[2];
#pragma unroll
    for (int i = 0; i < 2; ++i) { int R, C; stage_rc(tid * 16 + i * 8192, R, C); const int Rb = Epi::PERM ? ((R & ~31) + perm32(R & 31)) : R;
        voffA[i] = (unsigned)(R * K + C) * 2u; voffB[i] = (unsigned)(Rb * K + C) * 2u; }
    const size_t kstep = (size_t)(BK * 2);
    const size_t hstep = (size_t)HALF * K * 2;
    const size_t tstep = 2 * hstep;
    const size_t ahs = HALFM ? 0 : hstep;
    const unsigned ldsw = (unsigned)wid * 1024u;
    const int aoff = lds_byte(wr * 64 + fr, fq * 8), boff = lds_byte(wc * 32 + fr, fq * 8);
#define PG8_SA(b, h) (((b) * 2 + (h)) * HTB)
#define PG8_SB(b, h) ((4 + (b) * 2 + (h)) * HTB)
#define PG8_STAGE(bufoff, gbase, voff) do { _Pragma("unroll") for (int _i = 0; _i < 2; ++_i) \
        __builtin_amdgcn_global_load_lds((const unsigned*)((const char*)(gbase) + (voff)[_i]), (PG8_LAS unsigned*)(lds + (bufoff) + ldsw + _i * 8192), 16, 0, 0); } while (0)
#define PG8_LDA(dst, b, h) do { _Pragma("unroll") for (int m = 0; m < 4; ++m) _Pragma("unroll") for (int k = 0; k < 2; ++k) dst[m][k] = *(const PG8_LAS bf16x8*)(lds + PG8_SA(b, h) + aoff + m * 2048 + k * 1024); } while (0)
#define PG8_LDB(dst, b, h) do { _Pragma("unroll") for (int n = 0; n < 2; ++n) _Pragma("unroll") for (int k = 0; k < 2; ++k) dst[n][k] = *(const PG8_LAS bf16x8*)(lds + PG8_SB(b, h) + boff + n * 2048 + k * 1024); } while (0)
#define PG8_MMA(ai, bj, At, Bt) do { __builtin_amdgcn_s_setprio(1); _Pragma("unroll") for (int m = 0; m < 4; ++m) _Pragma("unroll") for (int n = 0; n < 2; ++n) _Pragma("unroll") for (int k = 0; k < 2; ++k) \
        acc[ai][bj][m][n] = __builtin_amdgcn_mfma_f32_16x16x32_bf16(Bt[n][k], At[m][k], acc[ai][bj][m][n], 0, 0, 0); __builtin_amdgcn_s_setprio(0); } while (0)
#define PG8_WAIT_V(n) asm volatile("s_waitcnt vmcnt(" #n ")" ::: "memory")
#define PG8_WAIT_L(n) asm volatile("s_waitcnt lgkmcnt(" #n ")" ::: "memory")
#define PG8_BAR __builtin_amdgcn_s_barrier()
#define PG8_SCHED __builtin_amdgcn_sched_barrier(0)
    Unit cur, nxt; int ui = 0;
    if (!S.next(0, cur)) return;
    f32x4 acc[2][2][4][2];
#pragma unroll
    for (int a = 0; a < 2; ++a)
#pragma unroll
        for (int b = 0; b < 2; ++b)
#pragma unroll
            for (int m = 0; m < 4; ++m)
#pragma unroll
                for (int n = 0; n < 2; ++n) acc[a][b][m][n] = (f32x4){0.f, 0.f, 0.f, 0.f};
    bf16x8 At[4][2], B0[2][2], B1[2][2];
    const char* cA = (const char*)g.A + (size_t)cur.pm * (HALFM ? hstep : tstep); const char* cB = (const char*)g.Bt + (size_t)cur.pn * tstep;
    S.a_ready(cur);
    PG8_STAGE(PG8_SB(0, 0), cB, voffB); PG8_STAGE(PG8_SA(0, 0), cA, voffA); PG8_STAGE(PG8_SB(0, 1), cB + hstep, voffB); PG8_STAGE(PG8_SA(0, 1), cA + ahs, voffA);
    if (wr == 1) PG8_BAR;
    PG8_WAIT_V(4); PG8_BAR;
    PG8_STAGE(PG8_SB(1, 0), cB + kstep, voffB); PG8_STAGE(PG8_SA(1, 0), cA + kstep, voffA); PG8_STAGE(PG8_SB(1, 1), cB + hstep + kstep, voffB);
    PG8_WAIT_V(6); PG8_BAR;
    PG8_STAMP();
    for (;;) {
        const bool has_next = S.next(ui + 1, nxt);
        const char* nA = has_next ? (const char*)g.A + (size_t)nxt.pm * (HALFM ? hstep : tstep) : cA; const char* nB = has_next ? (const char*)g.Bt + (size_t)nxt.pn * tstep : cB;
        for (int t = 0; t < nt; t += 2) {
            const bool last = (t == nt - 2);
            const char* a1 = cA + (size_t)(t + 1) * kstep;
            const char* a2 = last ? nA : cA + (size_t)(t + 2) * kstep; const char* b2 = last ? nB : cB + (size_t)(t + 2) * kstep;
            const char* a3 = a2 + kstep; const char* b3 = b2 + kstep;
            if (last && has_next) S.a_ready(nxt);
            PG8_LDB(B0, 0, 0); PG8_SCHED; PG8_LDA(At, 0, 0); PG8_STAGE(PG8_SA(1, 1), a1 + ahs, voffA);
            PG8_WAIT_L(8); PG8_BAR; PG8_WAIT_L(0); PG8_MMA(0, 0, At, B0); PG8_BAR; PG8_SCHED;
            PG8_LDB(B1, 0, 1); PG8_STAGE(PG8_SB(0, 0), b2, voffB);
            PG8_BAR; PG8_WAIT_L(0); PG8_MMA(0, 1, At, B1); PG8_BAR;
            if constexpr (!HALFM) { PG8_LDA(At, 0, 1); } PG8_STAGE(PG8_SA(0, 0), a2, voffA);
            PG8_BAR; PG8_WAIT_L(0); if constexpr (!HALFM) { PG8_MMA(1, 0, At, B0); } PG8_BAR; PG8_SCHED;
            PG8_STAGE(PG8_SB(0, 1), b2 + hstep, voffB);
            PG8_WAIT_V(6); PG8_BAR; if constexpr (!HALFM) { PG8_MMA(1, 1, At, B1); } PG8_BAR;
            PG8_LDB(B0, 1, 0); PG8_SCHED; PG8_LDA(At, 1, 0); PG8_STAGE(PG8_SA(0, 1), a2 + ahs, voffA);
            PG8_WAIT_L(8); PG8_BAR; PG8_WAIT_L(0); PG8_MMA(0, 0, At, B0); PG8_BAR; PG8_SCHED;
            PG8_LDB(B1, 1, 1); PG8_STAGE(PG8_SB(1, 0), b3, voffB);
            PG8_BAR; PG8_WAIT_L(0); PG8_MMA(0, 1, At, B1); PG8_BAR;
            if constexpr (!HALFM) { PG8_LDA(At, 1, 1); } PG8_STAGE(PG8_SA(1, 0), a3, voffA);
            PG8_BAR; PG8_WAIT_L(0); if constexpr (!HALFM) { PG8_MMA(1, 0, At, B0); } PG8_BAR; PG8_SCHED;
            PG8_STAGE(PG8_SB(1, 1), b3 + hstep, voffB);
            PG8_WAIT_V(6); PG8_BAR; if constexpr (!HALFM) { PG8_MMA(1, 1, At, B1); } PG8_BAR;
        }
        PG8_STAMP();
        if constexpr (!Epi::AFTER_DRAIN) { E(acc, cur, wr, wc, fr, fq); S.done(cur); }
        PG8_STAMP();
        if (!has_next) break;
#pragma unroll
        for (int a = 0; a < 2; ++a)
#pragma unroll
            for (int b = 0; b < 2; ++b)
#pragma unroll
                for (int m = 0; m < 4; ++m)
#pragma unroll
                    for (int n = 0; n < 2; ++n) acc[a][b][m][n] = (f32x4){0.f, 0.f, 0.f, 0.f};
        cur = nxt; cA = nA; cB = nB; ++ui;
    }
    PG8_WAIT_V(0);
    if (wr == 0) PG8_BAR;
    PG8_BAR;
    if constexpr (Epi::AFTER_DRAIN) { E.fused(acc, cur, wr, wc, fr, fq, lds, wid, lane); S.done(cur); }
    PG8_STAMP();
    if (STAMP && wid == 0) { stamps[lane] = lane < nts ? (((unsigned long long)(unsigned)ts_hi << 32) | (unsigned)ts_lo) : 0ull;
        if (lane == 62) stamps[62] = rt_entry; if (lane == 63) stamps[63] = (unsigned long long)wall_clock64(); }
#undef PG8_STAMP
#undef PG8_SA
#undef PG8_SB
#undef PG8_STAGE
#undef PG8_LDA
#undef PG8_LDB
#undef PG8_MMA
#undef PG8_WAIT_V
#undef PG8_WAIT_L
#undef PG8_BAR
#undef PG8_SCHED
}
}
namespace pg8 {
template <class Epi, class Sched, bool ALIGN_EPI = false, bool SP2 = false, bool HALFM = false>
__device__ __forceinline__ void gemm_phase2(PG8_LAS unsigned char* lds, const Gemm g, const Sched& S, const Epi& E) {
    int tid_l = threadIdx.x; asm volatile("" : "+v"(tid_l));
    const int tid = tid_l, wid = __builtin_amdgcn_readfirstlane(tid >> 6), lane = tid & 63, wr = wid >> 2, wc = wid & 3, fr = lane & 15, fq = lane >> 4;
    const int K = g.K, nt = K / BK;
    unsigned voffA[2], voffB[2];
#pragma unroll
    for (int i = 0; i < 2; ++i) { int R, C; stage_rc(tid * 16 + i * 8192, R, C); const int Rb = Epi::PERM ? ((R & ~31) + perm32(R & 31)) : R;
        voffA[i] = (unsigned)(R * K + C) * 2u; voffB[i] = (unsigned)(Rb * K + C) * 2u; }
    const size_t kstep = (size_t)(BK * 2);
    const size_t hstep = (size_t)HALF * K * 2;
    const size_t tstep = 2 * hstep;
    const size_t ahs = HALFM ? 0 : hstep;
    const unsigned ldsw = (unsigned)wid * 1024u;
    const int aoff = lds_byte(wr * 64 + fr, fq * 8), boff = lds_byte(wc * 32 + fr, fq * 8);
#define PG8_SA(b, h) (((b) * 2 + (h)) * HTB)
#define PG8_SB(b, h) ((4 + (b) * 2 + (h)) * HTB)
#define PG8_STAGE(bufoff, gbase, voff) do { _Pragma("unroll") for (int _i = 0; _i < 2; ++_i) \
        __builtin_amdgcn_global_load_lds((const unsigned*)((const char*)(gbase) + (voff)[_i]), (PG8_LAS unsigned*)(lds + (bufoff) + ldsw + _i * 8192), 16, 0, 0); } while (0)
#define PG8_LDA(dst, b, h) do { _Pragma("unroll") for (int m = 0; m < 4; ++m) _Pragma("unroll") for (int k = 0; k < 2; ++k) dst[m][k] = *(const PG8_LAS bf16x8*)(lds + PG8_SA(b, h) + aoff + m * 2048 + k * 1024); } while (0)
#define PG8_LDB(dst, b, h) do { _Pragma("unroll") for (int n = 0; n < 2; ++n) _Pragma("unroll") for (int k = 0; k < 2; ++k) dst[n][k] = *(const PG8_LAS bf16x8*)(lds + PG8_SB(b, h) + boff + n * 2048 + k * 1024); } while (0)
#define PG8_MMA(ai, bj, At, Bt) do { __builtin_amdgcn_s_setprio(1); _Pragma("unroll") for (int m = 0; m < 4; ++m) _Pragma("unroll") for (int n = 0; n < 2; ++n) _Pragma("unroll") for (int k = 0; k < 2; ++k) \
        acc[ai][bj][m][n] = __builtin_amdgcn_mfma_f32_16x16x32_bf16(Bt[n][k], At[m][k], acc[ai][bj][m][n], 0, 0, 0); __builtin_amdgcn_s_setprio(0); } while (0)
#define PG8_WAIT_V(n) asm volatile("s_waitcnt vmcnt(" #n ")" ::: "memory")
#define PG8_WAIT_L(n) asm volatile("s_waitcnt lgkmcnt(" #n ")" ::: "memory")
#define PG8_BAR __builtin_amdgcn_s_barrier()
#define PG8_SCHED __builtin_amdgcn_sched_barrier(0)
    Unit cur, nxt; int ui = 0;
    if (!S.next(0, cur)) return;
    f32x4 acc[2][2][4][2];
#pragma unroll
    for (int a = 0; a < 2; ++a)
#pragma unroll
        for (int b = 0; b < 2; ++b)
#pragma unroll
            for (int m = 0; m < 4; ++m)
#pragma unroll
                for (int n = 0; n < 2; ++n) acc[a][b][m][n] = (f32x4){0.f, 0.f, 0.f, 0.f};
    bf16x8 At[4][2], B0[2][2], B1[2][2];
    const char* cA = (const char*)g.A + (size_t)cur.pm * (HALFM ? hstep : tstep); const char* cB = (const char*)g.Bt + (size_t)cur.pn * tstep;
    S.a_ready(cur);
    if constexpr (SP2) {
        PG8_STAGE(PG8_SB(0, 0), cB, voffB); PG8_STAGE(PG8_SB(0, 1), cB + hstep, voffB); PG8_STAGE(PG8_SA(0, 0), cA, voffA); PG8_STAGE(PG8_SA(0, 1), cA + ahs, voffA);
        if (wr == 1) PG8_BAR;
        PG8_WAIT_V(2); PG8_BAR;
        PG8_STAGE(PG8_SB(1, 0), cB + kstep, voffB); PG8_STAGE(PG8_SA(1, 0), cA + kstep, voffA); PG8_STAGE(PG8_SB(1, 1), cB + hstep + kstep, voffB);
        PG8_WAIT_V(6); PG8_BAR;
    } else {
        PG8_STAGE(PG8_SB(0, 0), cB, voffB); PG8_STAGE(PG8_SA(0, 0), cA, voffA); PG8_STAGE(PG8_SB(0, 1), cB + hstep, voffB); PG8_STAGE(PG8_SA(0, 1), cA + ahs, voffA);
        if (wr == 1) PG8_BAR;
        PG8_WAIT_V(4); PG8_BAR;
        PG8_STAGE(PG8_SB(1, 0), cB + kstep, voffB); PG8_STAGE(PG8_SA(1, 0), cA + kstep, voffA); PG8_STAGE(PG8_SB(1, 1), cB + hstep + kstep, voffB);
        PG8_WAIT_V(6); PG8_BAR;
    }
    for (;;) {
        const bool has_next = S.next(ui + 1, nxt);
        const char* nA = has_next ? (const char*)g.A + (size_t)nxt.pm * (HALFM ? hstep : tstep) : cA; const char* nB = has_next ? (const char*)g.Bt + (size_t)nxt.pn * tstep : cB;
        for (int t = 0; t < nt; t += 2) {
            const bool last = (t == nt - 2);
            const char* a1 = cA + (size_t)(t + 1) * kstep;
            const char* a2 = last ? nA : cA + (size_t)(t + 2) * kstep; const char* b2 = last ? nB : cB + (size_t)(t + 2) * kstep;
            const char* a3 = a2 + kstep; const char* b3 = b2 + kstep;
            if (last && has_next) S.a_ready(nxt);
            if constexpr (SP2) {
            PG8_LDB(B0, 0, 0); PG8_LDB(B1, 0, 1); PG8_SCHED; PG8_LDA(At, 0, 0); PG8_STAGE(PG8_SA(1, 1), a1 + ahs, voffA);
            PG8_WAIT_V(8); PG8_WAIT_L(0); PG8_BAR; PG8_MMA(0, 0, At, B0); if constexpr (!HALFM) { PG8_MMA(0, 1, At, B1); } PG8_BAR; PG8_SCHED;
            if constexpr (!HALFM) { PG8_LDA(At, 0, 1); } PG8_STAGE(PG8_SB(0, 0), b2, voffB); PG8_STAGE(PG8_SB(0, 1), b2 + hstep, voffB); PG8_STAGE(PG8_SA(0, 0), a2, voffA);
            PG8_WAIT_V(8); PG8_WAIT_L(0); PG8_BAR; if constexpr (!HALFM) { PG8_MMA(1, 0, At, B0); PG8_MMA(1, 1, At, B1); } else { PG8_MMA(0, 1, At, B1); } PG8_BAR; PG8_SCHED;
            PG8_LDB(B0, 1, 0); PG8_LDB(B1, 1, 1); PG8_SCHED; PG8_LDA(At, 1, 0); PG8_STAGE(PG8_SA(0, 1), a2 + ahs, voffA);
            PG8_WAIT_V(8); PG8_WAIT_L(0); PG8_BAR; PG8_MMA(0, 0, At, B0); if constexpr (!HALFM) { PG8_MMA(0, 1, At, B1); } PG8_BAR; PG8_SCHED;
            if constexpr (!HALFM) { PG8_LDA(At, 1, 1); } PG8_STAGE(PG8_SB(1, 0), b3, voffB); PG8_STAGE(PG8_SB(1, 1), b3 + hstep, voffB); PG8_STAGE(PG8_SA(1, 0), a3, voffA);
            PG8_WAIT_V(8); PG8_WAIT_L(0); PG8_BAR; if constexpr (!HALFM) { PG8_MMA(1, 0, At, B0); PG8_MMA(1, 1, At, B1); } else { PG8_MMA(0, 1, At, B1); } PG8_BAR; PG8_SCHED;
            } else {
            PG8_LDB(B0, 0, 0); PG8_SCHED; PG8_LDA(At, 0, 0); PG8_STAGE(PG8_SA(1, 1), a1 + ahs, voffA);
            PG8_WAIT_L(8); PG8_BAR; PG8_WAIT_L(0); PG8_MMA(0, 0, At, B0); PG8_BAR; PG8_SCHED;
            PG8_LDB(B1, 0, 1); PG8_STAGE(PG8_SB(0, 0), b2, voffB);
            PG8_BAR; PG8_WAIT_L(0); PG8_MMA(0, 1, At, B1); PG8_BAR;
            if constexpr (!HALFM) { PG8_LDA(At, 0, 1); } PG8_STAGE(PG8_SA(0, 0), a2, voffA);
            PG8_BAR; PG8_WAIT_L(0); if constexpr (!HALFM) { PG8_MMA(1, 0, At, B0); } PG8_BAR; PG8_SCHED;
            PG8_STAGE(PG8_SB(0, 1), b2 + hstep, voffB);
            PG8_WAIT_V(6); PG8_BAR; if constexpr (!HALFM) { PG8_MMA(1, 1, At, B1); } PG8_BAR;
            PG8_LDB(B0, 1, 0); PG8_SCHED; PG8_LDA(At, 1, 0); PG8_STAGE(PG8_SA(0, 1), a2 + ahs, voffA);
            PG8_WAIT_L(8); PG8_BAR; PG8_WAIT_L(0); PG8_MMA(0, 0, At, B0); PG8_BAR; PG8_SCHED;
            PG8_LDB(B1, 1, 1); PG8_STAGE(PG8_SB(1, 0), b3, voffB);
            PG8_BAR; PG8_WAIT_L(0); PG8_MMA(0, 1, At, B1); PG8_BAR;
            if constexpr (!HALFM) { PG8_LDA(At, 1, 1); } PG8_STAGE(PG8_SA(1, 0), a3, voffA);
            PG8_BAR; PG8_WAIT_L(0); if constexpr (!HALFM) { PG8_MMA(1, 0, At, B0); } PG8_BAR; PG8_SCHED;
            PG8_STAGE(PG8_SB(1, 1), b3 + hstep, voffB);
            PG8_WAIT_V(6); PG8_BAR; if constexpr (!HALFM) { PG8_MMA(1, 1, At, B1); } PG8_BAR;
            }
        }
        if constexpr (ALIGN_EPI) { if (wr == 0) PG8_BAR; }
        if constexpr (!Epi::AFTER_DRAIN) { E(acc, cur, wr, wc, fr, fq); S.done(cur); }
        if (!has_next) break;
#pragma unroll
        for (int a = 0; a < 2; ++a)
#pragma unroll
            for (int b = 0; b < 2; ++b)
#pragma unroll
                for (int m = 0; m < 4; ++m)
#pragma unroll
                    for (int n = 0; n < 2; ++n) acc[a][b][m][n] = (f32x4){0.f, 0.f, 0.f, 0.f};
        cur = nxt; cA = nA; cB = nB; ++ui;
        if constexpr (ALIGN_EPI) { if (wr == 1) PG8_BAR; }
    }
    PG8_WAIT_V(0);
    if constexpr (!ALIGN_EPI) { if (wr == 0) PG8_BAR; }
    PG8_BAR;
    if constexpr (Epi::AFTER_DRAIN) { E.fused(acc, cur, wr, wc, fr, fq, lds, wid, lane); S.done(cur); }
#undef PG8_SA
#undef PG8_SB
#undef PG8_STAGE
#undef PG8_LDA
#undef PG8_LDB
#undef PG8_MMA
#undef PG8_WAIT_V
#undef PG8_WAIT_L
#undef PG8_BAR
#undef PG8_SCHED
}

}

#ifndef REPMASK
#define REPMASK 0u
#endif
constexpr int NTHR = 512;
constexpr int TOK = 8192;
constexpr float EPSF = 1e-6f;
constexpr size_t MiB = 1048576;
constexpr size_t WS_MOD = 0, WS_ATOT = 131072, WS_XBAR = 262144, WS_QCNT = 393216;
constexpr size_t WS_G = 1 * MiB, WS_TAB = 33 * MiB, WS_DT = 41 * MiB, WS_OATT = 43 * MiB;
constexpr size_t WS_HB = 59 * MiB, WS_BT = 59 * MiB, WS_YG = 59 * MiB;
constexpr size_t WS_WIN = 75 * MiB, WS_BN = 75 * MiB;
constexpr size_t WS_QK = 98 * MiB, WS_Z = 98 * MiB, WS_ACT = 98 * MiB;
constexpr size_t WS_V = 130 * MiB, WS_XBC = 130 * MiB, WS_YD = 130 * MiB, WS_MA = 130 * MiB;
constexpr size_t WS_QN = 146 * MiB, WS_KNI = 162 * MiB, WS_KNII = 170 * MiB, WS_VTI = 182 * MiB, WS_VTII = 190 * MiB;
constexpr size_t WS_YF = 162 * MiB, WS_MERGED = 162 * MiB, WS_H2 = 178 * MiB;
constexpr size_t WS_CN = 194 * MiB, WS_WD = 194 * MiB, WS_WA = 253 * MiB, WS_WB = 242 * MiB, WS_WOUT = 246 * MiB;
constexpr size_t WS_YB = 210 * MiB, WS_WGU = 242 * MiB;
constexpr size_t TABSZ = 64 * 8192;
constexpr int LDS_BYTES = 153600;

struct Params { const float* in[32]; float* out; unsigned char* ws; };

using pg8::Unit;
struct EpiIn1 {
    static constexpr bool PERM = true, AFTER_DRAIN = false;
    bf16_t* qk; bf16_t* v; bf16_t* g; float* dt; float* ncv;
    DI void operator()(const f32x4 (&acc)[2][2][4][2], const Unit& u, int wr, int wc, int fr, int fq) const {
        const int row0 = u.pm * 256 + wr * 64 + fr, cl = wc * 32 + 8 * fq, pn = u.pn;
        if (pn == 20) {
            if (wc < 2) {
#pragma unroll
                for (int ai = 0; ai < 2; ++ai)
#pragma unroll
                    for (int m = 0; m < 4; ++m) { float* d = dt + (size_t)(row0 + ai * 128 + m * 16) * 64 + cl; *(f32x4*)d = acc[ai][0][m][0]; *(f32x4*)(d + 4) = acc[ai][0][m][1]; }
            }
            return;
        }
        bf16_t* base; int ld;
        if (pn < 8) { base = qk + pn * 256; ld = 2048; } else if (pn < 12) { base = v + (pn - 8) * 256; ld = 1024; } else { base = g + (pn - 12) * 256; ld = 2048; }
        const bool isg = pn >= 12, isv = (pn >= 8 && pn < 12 && u.pm < 16);
#pragma unroll
        for (int ai = 0; ai < 2; ++ai)
#pragma unroll
            for (int m = 0; m < 4; ++m) {
                const int row = row0 + ai * 128 + m * 16;
#pragma unroll
                for (int bj = 0; bj < 2; ++bj) {
                    f32x4 v0 = acc[ai][bj][m][0], v1 = acc[ai][bj][m][1];
                    if (isv) { float* o = ncv + (size_t)row * 1024 + (pn - 8) * 256 + bj * 128 + cl; *(f32x4*)o = v0; *(f32x4*)(o + 4) = v1; }
                    if (isg) {
#pragma unroll
                        for (int j = 0; j < 4; ++j) { v0[j] = sigm(v0[j]); v1[j] = sigm(v1[j]); } }
                    u32x4 w; w[0] = pk2(v0[0], v0[1]); w[1] = pk2(v0[2], v0[3]); w[2] = pk2(v1[0], v1[1]); w[3] = pk2(v1[2], v1[3]);
                    *(u32x4*)(base + (size_t)row * ld + bj * 128 + cl) = w;
                }
            }
    }
};
struct EpiIn2 {
    static constexpr bool PERM = true, AFTER_DRAIN = false;
    bf16_t* z; bf16_t* xbc;
    DI void operator()(const f32x4 (&acc)[2][2][4][2], const Unit& u, int wr, int wc, int fr, int fq) const {
        const int row0 = u.pm * 256 + wr * 64 + fr, cl = wc * 32 + 8 * fq, pn = u.pn;
        bf16_t* base; int ld;
        if (pn < 8) { base = z + pn * 256; ld = 2048; } else { base = xbc + (pn - 8) * 256; ld = 4096; }
#pragma unroll
        for (int ai = 0; ai < 2; ++ai)
#pragma unroll
            for (int m = 0; m < 4; ++m) {
                const int row = row0 + ai * 128 + m * 16;
#pragma unroll
                for (int bj = 0; bj < 2; ++bj) {
                    const f32x4 v0 = acc[ai][bj][m][0], v1 = acc[ai][bj][m][1];
                    u32x4 w; w[0] = pk2(v0[0], v0[1]); w[1] = pk2(v0[2], v0[3]); w[2] = pk2(v1[0], v1[1]); w[3] = pk2(v1[2], v1[3]);
                    *(u32x4*)(base + (size_t)row * ld + bj * 128 + cl) = w;
                }
            }
    }
};
template <int SECOND, int HM> struct EpiBranch {
    static constexpr bool PERM = true, AFTER_DRAIN = false;
    const bf16_t* g; bf16_t* m2; u32x4* keep;
    DI void operator()(const f32x4 (&acc)[2][2][4][2], const Unit& u, int wr, int wc, int fr, int fq) const {
        const int row0 = u.pm * (HM ? 128 : 256) + wr * 64 + fr, col0 = u.pn * 256 + wc * 32 + 8 * fq;
        constexpr int NQ = HM ? 4 : 8;
#pragma unroll
        for (int bj = 0; bj < 2; ++bj) {
            const int c = col0 + bj * 128;
            u32x4 gg[NQ];
#pragma unroll
            for (int q = 0; q < NQ; ++q) { const int row = row0 + (q >> 2) * 128 + (q & 3) * 16; gg[q] = *(const u32x4*)(g + (size_t)row * 2048 + SECOND * 1024 + c); }
#pragma unroll
            for (int q = 0; q < NQ; ++q) { const int row = row0 + (q >> 2) * 128 + (q & 3) * 16;
                const f32x4 a0 = acc[q >> 2][bj][q & 3][0], a1 = acc[q >> 2][bj][q & 3][1];
                float r[8];
                r[0] = bflo(gg[q][0]) * a0[0]; r[1] = bfhi(gg[q][0]) * a0[1]; r[2] = bflo(gg[q][1]) * a0[2]; r[3] = bfhi(gg[q][1]) * a0[3];
                r[4] = bflo(gg[q][2]) * a1[0]; r[5] = bfhi(gg[q][2]) * a1[1]; r[6] = bflo(gg[q][3]) * a1[2]; r[7] = bfhi(gg[q][3]) * a1[3];
                if (SECOND == 0) { const u32x4 pv = keep[bj * NQ + q];
#pragma unroll
                    for (int j = 0; j < 4; ++j) { r[2 * j] += bflo(pv[j]); r[2 * j + 1] += bfhi(pv[j]); } }
                u32x4 w; w[0] = pk2(r[0], r[1]); w[1] = pk2(r[2], r[3]); w[2] = pk2(r[4], r[5]); w[3] = pk2(r[6], r[7]);
                if (SECOND == 1) keep[bj * NQ + q] = w; else *(u32x4*)(m2 + (size_t)row * 1024 + c) = w; }
        }
    }
};
template <int FINAL, int HM> struct EpiRes {
    static constexpr bool PERM = false, AFTER_DRAIN = false;
    const float* xa; const float* xb; const float* mod; float* out;
    DI void operator()(const f32x4 (&acc)[2][2][4][2], const Unit& u, int wr, int wc, int fr, int fq) const {
        const int row0 = u.pm * (HM ? 128 : 256) + wr * 64 + fr, col0 = u.pn * 256 + wc * 32 + 4 * fq;
        const int pm256 = HM ? (u.pm >> 1) : u.pm;
        const int mi = pm256 < 16 ? 0 : 1 + ((pm256 - 16) >> 2);
        const float* gate = mod + mi * 6144 + (FINAL ? 5120 : 2048);
        constexpr int NQ = HM ? 4 : 8;
#pragma unroll
        for (int bj = 0; bj < 2; ++bj)
#pragma unroll
            for (int n = 0; n < 2; ++n) {
                const int c = col0 + bj * 128 + n * 16;
                const f32x4 gt = *(const f32x4*)(gate + c);
                f32x4 xv[NQ];
#pragma unroll
                for (int q = 0; q < NQ; ++q) { const int row = row0 + (q >> 2) * 128 + (q & 3) * 16;
                    const float* xp = FINAL ? (out + (size_t)row * 1024 + c) : ((row < 4096 ? xa + (size_t)row * 1024 : xb + (size_t)(row - 4096) * 1024) + c);
                    xv[q] = *(const f32x4*)xp; }
#pragma unroll
                for (int q = 0; q < NQ; ++q) { const int row = row0 + (q >> 2) * 128 + (q & 3) * 16;
                    *(f32x4*)(out + (size_t)row * 1024 + c) = xv[q] + gt * acc[q >> 2][bj][q & 3][n]; }
            }
    }
};
struct EpiUp {
    static constexpr bool PERM = true, AFTER_DRAIN = false;
    bf16_t* act;
    DI void operator()(const f32x4 (&acc)[2][2][4][2], const Unit& u, int wr, int wc, int fr, int fq) const {
        const int row0 = u.pm * 256 + wr * 64 + fr, col = u.pn * 128 + wc * 32 + 8 * fq;
#pragma unroll
        for (int ai = 0; ai < 2; ++ai)
#pragma unroll
            for (int m = 0; m < 4; ++m) {
                const int row = row0 + ai * 128 + m * 16;
                float r[8];
#pragma unroll
                for (int n = 0; n < 2; ++n)
#pragma unroll
                    for (int j = 0; j < 4; ++j) r[n * 4 + j] = silu(acc[ai][0][m][n][j]) * acc[ai][1][m][n][j];
                u32x4 w; w[0] = pk2(r[0], r[1]); w[1] = pk2(r[2], r[3]); w[2] = pk2(r[4], r[5]); w[3] = pk2(r[6], r[7]);
                *(u32x4*)(act + (size_t)row * 2816 + col) = w;
            }
    }
};

struct WT { const float* src; bf16_t* dst; int N, K; };
struct Params;
template <int WHICH> DI WT wt_decode(const float* const* in, unsigned char* ws, int t);
template <int WHICH> DI void wconv_loop(const float* const* in, unsigned char* ws, int ntiles, int t0, int tstride, unsigned char* lds, int tid) {
    asm volatile("" : "+v"(tid));
    bf16_t* T = (bf16_t*)lds;
    int t = t0; if (t >= ntiles) return;
    WT cur = wt_decode<WHICH>(in, ws, t);
    const int kr0 = tid >> 4, c4 = tid & 15;
    f32x4 r0 = {0.f, 0.f, 0.f, 0.f}, r1 = r0;
    if (cur.src) { r0 = *(const f32x4*)(cur.src + (size_t)kr0 * cur.N + 4 * c4); r1 = *(const f32x4*)(cur.src + (size_t)(kr0 + 32) * cur.N + 4 * c4); }
    for (;;) {
        const int tn = t + tstride; const bool has = tn < ntiles;
        WT nx = cur; f32x4 n0 = {0.f, 0.f, 0.f, 0.f}, n1 = n0;
        if (has) { nx = wt_decode<WHICH>(in, ws, tn);
            if (nx.src) { n0 = *(const f32x4*)(nx.src + (size_t)kr0 * nx.N + 4 * c4); n1 = *(const f32x4*)(nx.src + (size_t)(kr0 + 32) * nx.N + 4 * c4); } }
        { u32x2 w; w[0] = pk2(r0[0], r0[1]); w[1] = pk2(r0[2], r0[3]); *(u32x2*)(T + kr0 * 68 + 4 * c4) = w;
          u32x2 x; x[0] = pk2(r1[0], r1[1]); x[1] = pk2(r1[2], r1[3]); *(u32x2*)(T + (kr0 + 32) * 68 + 4 * c4) = x; }
        __syncthreads();
        { const int n = tid & 63, kq = tid >> 6; u32x4 w;
#pragma unroll
          for (int j = 0; j < 4; ++j) { const unsigned lo = T[(kq * 8 + 2 * j) * 68 + n], hi = T[(kq * 8 + 2 * j + 1) * 68 + n]; w[j] = lo | (hi << 16); }
          *(u32x4*)(cur.dst + (size_t)n * cur.K + kq * 8) = w; }
        __syncthreads();
        if (!has) break;
        cur = nx; r0 = n0; r1 = n1; t = tn;
    }
}
template <> DI WT wt_decode<0>(const float* const* in, unsigned char* ws, int t) {
    const int nb = t >> 4, kb = t & 15, nd = nb * 64; int ns;
    if (nd < 3072) ns = nd; else if (nd < 5120) ns = 9280 + (nd - 3072); else if (nd < 5184) ns = 9216 + (nd - 5120); else if (nd < 5376) ns = -1; else ns = 3072 + (nd - 5376);
    WT w; w.N = 11328; w.K = 1024; w.src = ns < 0 ? nullptr : in[12] + (size_t)(kb * 64) * 11328 + ns; w.dst = (bf16_t*)(ws + 75 * 1048576) + (size_t)nd * 1024 + kb * 64; return w;
}
template <> DI WT wt_decode<1>(const float* const* in, unsigned char* ws, int t) {
    WT w;
    if (t < 256) { const int nb = t >> 4, kb = t & 15; w.N = 1024; w.K = 1024; w.src = in[26] + (size_t)(kb * 64) * 1024 + nb * 64; w.dst = (bf16_t*)(ws + 253 * 1048576) + (size_t)(nb * 64) * 1024 + kb * 64; }
    else if (t < 768) { const int q = t - 256, nb = q >> 5, kb = q & 31; w.N = 1024; w.K = 2048; w.src = in[27] + (size_t)(kb * 64) * 1024 + nb * 64; w.dst = (bf16_t*)(ws + 242 * 1048576) + (size_t)(nb * 64) * 2048 + kb * 64; }
    else { const int q = t - 768, nb = q >> 4, kb = q & 15; w.N = 1024; w.K = 1024; w.src = in[28] + (size_t)(kb * 64) * 1024 + nb * 64; w.dst = (bf16_t*)(ws + 246 * 1048576) + (size_t)(nb * 64) * 1024 + kb * 64; }
    return w;
}
template <> DI WT wt_decode<2>(const float* const* in, unsigned char* ws, int t) {
    WT w;
    if (t < 1408) { const int nb = t >> 4, kb = t & 15, pn = nb >> 2, qq = nb & 3; w.N = 2816; w.K = 1024;
        w.src = (qq < 2 ? in[29] : in[30]) + (size_t)(kb * 64) * 2816 + pn * 128 + (qq & 1) * 64; w.dst = (bf16_t*)(ws + 242 * 1048576) + (size_t)(nb * 64) * 1024 + kb * 64; }
    else { const int q = t - 1408, nb = q / 44, kb = q % 44; w.N = 1024; w.K = 2816; w.src = in[31] + (size_t)(kb * 64) * 1024 + nb * 64; w.dst = (bf16_t*)(ws + 194 * 1048576) + (size_t)(nb * 64) * 2816 + kb * 64; }
    return w;
}

DI void norm_rows(const float* __restrict__ xa, const float* __restrict__ xb, const float* __restrict__ g, const float* __restrict__ mod, int shift_off, int scale_off, bf16_t* __restrict__ dst, int gw, int nw, int lane) {
    asm volatile("" : "+v"(lane));
#pragma unroll 2
    for (int row = gw; row < TOK; row += nw) {
        const float* xr = row < 4096 ? xa + (size_t)row * 1024 : xb + (size_t)(row - 4096) * 1024;
        const float* mm = mod + (row < 4096 ? 0 : 1 + ((row - 4096) >> 10)) * 6144;
        f32x4 v[4], ggv[4], scv[4], shv[4]; float ss = 0.f;
#pragma unroll
        for (int i = 0; i < 4; ++i) { const int c = lane * 16 + i * 4; v[i] = *(const f32x4*)(xr + c); ggv[i] = *(const f32x4*)(g + c); scv[i] = *(const f32x4*)(mm + scale_off + c); shv[i] = *(const f32x4*)(mm + shift_off + c); }
#pragma unroll
        for (int i = 0; i < 4; ++i) ss += v[i][0] * v[i][0] + v[i][1] * v[i][1] + v[i][2] * v[i][2] + v[i][3] * v[i][3];
        ss = wsum(ss);
        const float rstd = rsqrtf(ss * (1.0f / 1024.0f) + EPSF);
        u32x4 w[2];
#pragma unroll
        for (int i = 0; i < 4; ++i) {
            const f32x4 gg = ggv[i], sc = scv[i], sh = shv[i];
            f32x4 h;
#pragma unroll
            for (int j = 0; j < 4; ++j) h[j] = v[i][j] * rstd * gg[j] * (1.0f + sc[j]) + sh[j];
            w[i >> 1][(i & 1) * 2] = pk2(h[0], h[1]); w[i >> 1][(i & 1) * 2 + 1] = pk2(h[2], h[3]); }
        *(u32x4*)(dst + (size_t)row * 1024 + lane * 16) = w[0]; *(u32x4*)(dst + (size_t)row * 1024 + lane * 16 + 8) = w[1];
    }
}

constexpr int AT_KST = 144, AT_VST = 144, AT_K1 = 64 * AT_KST, AT_V = 2 * 64 * AT_KST, AT_BUF = AT_V + 128 * AT_VST;
DI void attn_unit(const bf16_t* __restrict__ q0p, const bf16_t* __restrict__ q1p, const bf16_t* __restrict__ k0p, const bf16_t* __restrict__ k1p,
                  const bf16_t* __restrict__ vtp, int ldv, int nk, bf16_t* __restrict__ outp, float lam, const float* __restrict__ subg, unsigned char* lds, int tid) {
    asm volatile("" : "+v"(tid));
    const int lane = tid & 63, wv = tid >> 6, r = lane & 31, hh = lane >> 5, comp = wv >> 2, qg = wv & 3;
    const bf16_t* qp = (comp ? q1p : q0p) + (size_t)(qg * 32 + r) * 64 + hh * 8;
    bf16x8 qf[4];
#pragma unroll
    for (int ks = 0; ks < 4; ++ks) qf[ks] = *(const bf16x8*)(qp + ks * 16);
    f32x16 o[4];
#pragma unroll
    for (int i = 0; i < 4; ++i) o[i] = zero16();
    float l = 0.f;
    const int kc0 = tid, kc1 = tid + 512;
    const bf16_t* kg0 = (kc0 >> 9 ? k1p : k0p) + (size_t)((kc0 >> 3) & 63) * 64 + (kc0 & 7) * 8;
    const bf16_t* kg1 = (kc1 >> 9 ? k1p : k0p) + (size_t)((kc1 >> 3) & 63) * 64 + (kc1 & 7) * 8;
    const int kl0 = (kc0 >> 9) * AT_K1 + ((kc0 >> 3) & 63) * AT_KST + (kc0 & 7) * 16, kl1 = (kc1 >> 9) * AT_K1 + ((kc1 >> 3) & 63) * AT_KST + (kc1 & 7) * 16;
    const bf16_t* vg0 = vtp + (size_t)(kc0 >> 3) * ldv + (kc0 & 7) * 8; const bf16_t* vg1 = vtp + (size_t)(kc1 >> 3) * ldv + (kc1 & 7) * 8;
    const int vl0 = AT_V + (kc0 >> 3) * AT_VST + ((kc0 & 7) >> 1) * 32 + (kc0 & 1) * 8, vl1 = AT_V + (kc1 >> 3) * AT_VST + ((kc1 & 7) >> 1) * 32 + (kc1 & 1) * 8;
    u32x4 sa[4], sb[4];
#define AT_LOAD(S, tt) do { const size_t ko_ = (size_t)(tt) * 64 * 64; const int vo_ = (tt) * 64; \
        const bf16_t* p0_ = kg0 + ko_; const bf16_t* p1_ = kg1 + ko_; const bf16_t* p2_ = vg0 + vo_; const bf16_t* p3_ = vg1 + vo_; \
        asm volatile("global_load_dwordx4 %0, %1, off" : "=v"(S[0]) : "v"(p0_) : "memory"); asm volatile("global_load_dwordx4 %0, %1, off" : "=v"(S[1]) : "v"(p1_) : "memory"); \
        asm volatile("global_load_dwordx4 %0, %1, off" : "=v"(S[2]) : "v"(p2_) : "memory"); asm volatile("global_load_dwordx4 %0, %1, off" : "=v"(S[3]) : "v"(p3_) : "memory"); } while (0)
#define AT_WAIT4(S) asm volatile("s_waitcnt vmcnt(4)" : "+v"(S[0]), "+v"(S[1]), "+v"(S[2]), "+v"(S[3]) : : "memory")
#define AT_WAIT0(S) asm volatile("s_waitcnt vmcnt(0)" : "+v"(S[0]), "+v"(S[1]), "+v"(S[2]), "+v"(S[3]) : : "memory")
#define AT_STORE(S, W) do { *(u32x4*)((W) + kl0) = S[0]; *(u32x4*)((W) + kl1) = S[1]; \
        *(u32x2*)((W) + vl0) = (u32x2){S[2][0], S[2][1]}; *(u32x2*)((W) + vl0 + 16) = (u32x2){S[2][2], S[2][3]}; \
        *(u32x2*)((W) + vl1) = (u32x2){S[3][0], S[3][1]}; *(u32x2*)((W) + vl1 + 16) = (u32x2){S[3][2], S[3][3]}; } while (0)
#define AT_COMPUTE(B) do { _Pragma("unroll") for (int kh = 0; kh < 2; ++kh) { \
            f32x16 s_ = zero16(); \
            _Pragma("unroll") for (int ks = 0; ks < 4; ++ks) s_ = MFMA32(*(const bf16x8*)((B) + kro + kh * 32 * AT_KST + ks * 32), qf[ks], s_); \
            _Pragma("unroll") for (int i = 0; i < 16; ++i) { s_[i] = __builtin_amdgcn_exp2f(s_[i]); l += s_[i]; } \
            const bf16x8 p0 = pack8<0>(s_), p1 = pack8<1>(s_); \
            _Pragma("unroll") for (int vt = 0; vt < 4; ++vt) { const unsigned char* vv = (B) + vro + vt * 32 * AT_VST + kh * 64; \
                const bf16x8 v0 = *(const bf16x8*)(vv), v1 = *(const bf16x8*)(vv + 32); \
                o[vt] = MFMA32(v0, p0, o[vt]); o[vt] = MFMA32(v1, p1, o[vt]); } } } while (0)
    const int nt = nk >> 6;
    const int kro = comp * AT_K1 + r * AT_KST + hh * 16, vro = AT_V + r * AT_VST + hh * 16;
    asm volatile("" : : "v"(qf[0]), "v"(qf[1]), "v"(qf[2]), "v"(qf[3]));
    AT_LOAD(sa, 0); AT_WAIT0(sa); AT_STORE(sa, lds);
    AT_LOAD(sa, 1);
    __syncthreads();
#pragma unroll 1
    for (int t = 0; t + 2 < nt; t += 2) {
        AT_LOAD(sb, t + 2);
        AT_COMPUTE(lds);
        AT_WAIT4(sa); AT_STORE(sa, lds + AT_BUF);
        __syncthreads();
        AT_LOAD(sa, t + 3);
        AT_COMPUTE(lds + AT_BUF);
        AT_WAIT4(sb); AT_STORE(sb, lds);
        __syncthreads();
    }
    AT_COMPUTE(lds);
    AT_WAIT0(sa); AT_STORE(sa, lds + AT_BUF);
    __syncthreads();
    AT_COMPUTE(lds + AT_BUF);
    __syncthreads();
#undef AT_LOAD
#undef AT_STORE
#undef AT_COMPUTE
#undef AT_WAIT4
#undef AT_WAIT0
    l += __shfl_xor(l, 32);
    float* X = (float*)lds;
    if (comp) { const float i1 = lam / l;
#pragma unroll
        for (int vt = 0; vt < 4; ++vt)
#pragma unroll
            for (int i = 0; i < 16; ++i) X[((qg * 4 + vt) * 16 + i) * 64 + lane] = o[vt][i] * i1; }
    __syncthreads();
    if (!comp) { const float i0 = 1.0f / l; float ss = 0.f;
#pragma unroll
        for (int vt = 0; vt < 4; ++vt)
#pragma unroll
            for (int i = 0; i < 16; ++i) { const float tv = o[vt][i] * i0 - X[((qg * 4 + vt) * 16 + i) * 64 + lane]; o[vt][i] = tv; ss += tv * tv; }
        ss += __shfl_xor(ss, 32);
        const float rs = rsqrtf(ss * (1.0f / 128.0f) + EPSF) * 0.8f;
        f32x4 sgv[16];
#pragma unroll
        for (int q = 0; q < 16; ++q) sgv[q] = *(const f32x4*)(subg + (q >> 2) * 32 + 8 * (q & 3) + 4 * hh);
#pragma unroll
        for (int vt = 0; vt < 4; ++vt)
#pragma unroll
            for (int g4 = 0; g4 < 4; ++g4) { const int vd0 = vt * 32 + 8 * g4 + 4 * hh; const f32x4 sg = sgv[vt * 4 + g4];
                u32x2 w; w[0] = pk2(o[vt][4 * g4] * rs * sg[0], o[vt][4 * g4 + 1] * rs * sg[1]); w[1] = pk2(o[vt][4 * g4 + 2] * rs * sg[2], o[vt][4 * g4 + 3] * rs * sg[3]);
                *(u32x2*)(outp + (size_t)(qg * 32 + r) * 1024 + vd0) = w; } }
    __syncthreads();
}

DI void store_yT1(const f32x16& y, float sc, bf16_t* __restrict__ yrow, int hh) {
#pragma unroll
    for (int g4 = 0; g4 < 4; ++g4) { u32x2 w; w[0] = pk2(y[4 * g4] * sc, y[4 * g4 + 1] * sc); w[1] = pk2(y[4 * g4 + 2] * sc, y[4 * g4 + 3] * sc); *(u32x2*)(yrow + 8 * g4 + 4 * hh) = w; }
}

DI void scan_item(int seq, int head, int dir, int pt, const bf16_t* __restrict__ XT, const bf16_t* __restrict__ BT, const bf16_t* __restrict__ CN,
                  const float* __restrict__ TE, const float* __restrict__ TW, const float* __restrict__ ATOT, const float* __restrict__ st_in, float* __restrict__ st_out,
                  bf16_t* __restrict__ Y, int lane) {
    const int r = lane & 31, hh = lane >> 5, g = head >> 2, col = dir * 32 + head;
    const int T0 = seq < 16 ? seq * 256 : 4096 + (seq - 16) * 1024, nc = seq < 16 ? 2 : 8;
    f32x16 H[4];
    if (seq < 16) {
#pragma unroll
        for (int nt = 0; nt < 4; ++nt) H[nt] = zero16();
    } else {
        const float* sp = st_in + ((size_t)((seq - 16) * 32 + head) * 64) * 128;
#pragma unroll
        for (int nt = 0; nt < 4; ++nt)
#pragma unroll
            for (int g4 = 0; g4 < 4; ++g4) { const f32x4 v = *(const f32x4*)(sp + (size_t)(pt * 32 + r) * 128 + nt * 32 + 8 * g4 + 4 * hh);
                H[nt][4 * g4] = v[0]; H[nt][4 * g4 + 1] = v[1]; H[nt][4 * g4 + 2] = v[2]; H[nt][4 * g4 + 3] = v[3]; }
    }
    const bf16_t* xrow = XT + (size_t)(head * 64 + pt * 32 + r) * 8192;
#pragma unroll 1
    for (int cc = 0; cc < nc; ++cc) {
        const int c = dir ? nc - 1 - cc : cc, t0 = T0 + c * 128;
        {
            bf16x8 hp[4][2];
#pragma unroll
            for (int nt = 0; nt < 4; ++nt) { hp[nt][0] = pack8<0>(H[nt]); hp[nt][1] = pack8<1>(H[nt]); }
#pragma unroll 1
            for (int lh = 0; lh < 2; ++lh) {
                s16x4 cl[2][4][4]; float ev[2];
#pragma unroll
                for (int l2 = 0; l2 < 2; ++l2) { const int lt = lh * 2 + l2; const bf16_t* cp = CN + (size_t)(t0 + lt * 32 + r) * 1024 + g * 128 + 4 * hh;
                    ev[l2] = TE[(size_t)col * 8192 + t0 + lt * 32 + r];
#pragma unroll
                    for (int nt = 0; nt < 4; ++nt)
#pragma unroll
                        for (int q = 0; q < 4; ++q) cl[l2][nt][q] = *(const s16x4*)(cp + nt * 32 + q * 8); }
#pragma unroll
                for (int l2 = 0; l2 < 2; ++l2) { const int lt = lh * 2 + l2;
                    f32x16 y = zero16();
#pragma unroll
                    for (int nt = 0; nt < 4; ++nt) { y = MFMA32(hp[nt][0], cat4(cl[l2][nt][0], cl[l2][nt][1]), y); y = MFMA32(hp[nt][1], cat4(cl[l2][nt][2], cl[l2][nt][3]), y); }
                    store_yT1(y, ev[l2], Y + (size_t)(t0 + lt * 32 + r) * 2048 + head * 64 + pt * 32, hh);
                }
            }
        }
        const float at = ATOT[(t0 >> 7) * 64 + col];
#pragma unroll
        for (int nt = 0; nt < 4; ++nt) H[nt] *= at;
#pragma unroll 1
        for (int kb = 0; kb < 2; ++kb) {
            bf16x8 bfr[4][4]; u32x4 xr[4]; f32x4 w0[4], w1[4];
#pragma unroll
            for (int k4 = 0; k4 < 4; ++k4) { const int so = t0 + (kb * 4 + k4) * 16 + hh * 8;
                xr[k4] = *(const u32x4*)(xrow + so); w0[k4] = *(const f32x4*)(TW + (size_t)col * 8192 + so); w1[k4] = *(const f32x4*)(TW + (size_t)col * 8192 + so + 4);
#pragma unroll
                for (int nt = 0; nt < 4; ++nt) bfr[k4][nt] = *(const bf16x8*)(BT + (size_t)(g * 128 + nt * 32 + r) * 8192 + so); }
#pragma unroll
            for (int k4 = 0; k4 < 4; ++k4) {
                u32x4 xs; xs[0] = pk2(bflo(xr[k4][0]) * w0[k4][0], bfhi(xr[k4][0]) * w0[k4][1]); xs[1] = pk2(bflo(xr[k4][1]) * w0[k4][2], bfhi(xr[k4][1]) * w0[k4][3]);
                xs[2] = pk2(bflo(xr[k4][2]) * w1[k4][0], bfhi(xr[k4][2]) * w1[k4][1]); xs[3] = pk2(bflo(xr[k4][3]) * w1[k4][2], bfhi(xr[k4][3]) * w1[k4][3]);
                const bf16x8 xf = __builtin_bit_cast(bf16x8, xs);
#pragma unroll
                for (int nt = 0; nt < 4; ++nt) H[nt] = MFMA32(bfr[k4][nt], xf, H[nt]);
            }
        }
    }
    if (seq < 16) {
        float* sp = st_out + ((size_t)(seq * 32 + head) * 64) * 128;
#pragma unroll
        for (int nt = 0; nt < 4; ++nt)
#pragma unroll
            for (int g4 = 0; g4 < 4; ++g4) { f32x4 v; v[0] = H[nt][4 * g4]; v[1] = H[nt][4 * g4 + 1]; v[2] = H[nt][4 * g4 + 2]; v[3] = H[nt][4 * g4 + 3];
                *(f32x4*)(sp + (size_t)(pt * 32 + r) * 128 + nt * 32 + 8 * g4 + 4 * hh) = v; }
    }
}

DI void diag_item(int sc, int head, int lt, const bf16_t* __restrict__ XT, const bf16_t* __restrict__ BN, const bf16_t* __restrict__ CN,
                  const float* __restrict__ CUM, const float* __restrict__ DTT, const float* __restrict__ Dskip, bf16_t* __restrict__ Y, int lane) {
    const int r = lane & 31, hh = lane >> 5, g = head >> 2, t0 = sc * 128, l = lt * 32 + r;
    bf16x8 cf[8];
#pragma unroll
    for (int ks = 0; ks < 8; ++ks) cf[ks] = *(const bf16x8*)(CN + (size_t)(t0 + l) * 1024 + g * 128 + ks * 16 + hh * 8);
    const float* cumf = CUM + (size_t)head * 8192 + t0; const float* cumb = CUM + (size_t)(32 + head) * 8192 + t0;
    const float* dtf = DTT + (size_t)head * 8192 + t0; const float* dtb = DTT + (size_t)(32 + head) * 8192 + t0;
    const float cfl = cumf[l], rbl = cumb[l], dsum = dtf[l] + dtb[l];
    f32x16 y0 = zero16(), y1 = zero16();
#pragma unroll 1
    for (int st = 0; st < 4; ++st) {
        bf16x8 bfr[8]; f32x4 cfs[4], dfs[4], rbs[4], dbs[4]; s16x4 xa[2][4];
#pragma unroll
        for (int ks = 0; ks < 8; ++ks) bfr[ks] = *(const bf16x8*)(BN + (size_t)(t0 + st * 32 + r) * 1024 + g * 128 + ks * 16 + hh * 8);
#pragma unroll
        for (int g4 = 0; g4 < 4; ++g4) { const int s0 = st * 32 + 8 * g4 + 4 * hh;
            cfs[g4] = *(const f32x4*)(cumf + s0); dfs[g4] = *(const f32x4*)(dtf + s0); rbs[g4] = *(const f32x4*)(cumb + s0); dbs[g4] = *(const f32x4*)(dtb + s0); }
#pragma unroll
        for (int pt = 0; pt < 2; ++pt) { const bf16_t* ap = XT + (size_t)(head * 64 + pt * 32 + r) * 8192 + t0 + st * 32 + 4 * hh;
#pragma unroll
            for (int q = 0; q < 4; ++q) xa[pt][q] = *(const s16x4*)(ap + q * 8); }
        f32x16 x = zero16();
#pragma unroll
        for (int ks = 0; ks < 8; ++ks) x = MFMA32(bfr[ks], cf[ks], x);
#pragma unroll
        for (int g4 = 0; g4 < 4; ++g4) { const int s0 = st * 32 + 8 * g4 + 4 * hh;
#pragma unroll
            for (int j = 0; j < 4; ++j) { const int sI = s0 + j;
                const float arg = sI < l ? cfl - cfs[g4][j] : rbl - rbs[g4][j];
                const float e = __expf(fminf(arg, 0.f));
                const float val = sI < l ? e * dfs[g4][j] : (sI > l ? e * dbs[g4][j] : dsum);
                x[4 * g4 + j] *= val; } }
        const bf16x8 m0 = pack8<0>(x), m1 = pack8<1>(x);
        y0 = MFMA32(cat4(xa[0][0], xa[0][1]), m0, y0); y0 = MFMA32(cat4(xa[0][2], xa[0][3]), m1, y0);
        y1 = MFMA32(cat4(xa[1][0], xa[1][1]), m0, y1); y1 = MFMA32(cat4(xa[1][2], xa[1][3]), m1, y1);
    }
    const float dsk = Dskip[head];
#pragma unroll
    for (int i = 0; i < 16; ++i) { const int p = (i & 3) + 8 * (i >> 2) + 4 * hh;
        y0[i] += dsk * __uint_as_float((unsigned)XT[(size_t)(head * 64 + p) * 8192 + t0 + l] << 16);
        y1[i] += dsk * __uint_as_float((unsigned)XT[(size_t)(head * 64 + 32 + p) * 8192 + t0 + l] << 16); }
    store_yT1(y0, 1.0f, Y + (size_t)(t0 + l) * 2048 + head * 64, hh); store_yT1(y1, 1.0f, Y + (size_t)(t0 + l) * 2048 + head * 64 + 32, hh);
}

DI void store_yT_wide(const f32x16& y, float sc, bf16_t* __restrict__ yrow  , int hh) {
#pragma unroll
    for (int kp = 0; kp < 2; ++kp) {
        unsigned ax = pk2(y[8 * kp + 0] * sc, y[8 * kp + 1] * sc), ay = pk2(y[8 * kp + 2] * sc, y[8 * kp + 3] * sc);
        unsigned bx = pk2(y[8 * kp + 4] * sc, y[8 * kp + 5] * sc), by = pk2(y[8 * kp + 6] * sc, y[8 * kp + 7] * sc);
        { auto r0 = __builtin_amdgcn_permlane32_swap(ax, bx, false, false); ax = r0[0]; bx = r0[1]; }
        { auto r1 = __builtin_amdgcn_permlane32_swap(ay, by, false, false); ay = r1[0]; by = r1[1]; }
        u32x4 w; w[0] = ax; w[1] = ay; w[2] = bx; w[3] = by;
        *(u32x4*)(yrow + 16 * kp + 8 * hh) = w;
    }
}

constexpr int SB_C = 0, SB_BT = 34816, SB_TE = 69632, SB_TW = 71680, SB_BUF = 73728;
DI void scan_block(int seq, int g, int dir, const bf16_t* __restrict__ XT, const bf16_t* __restrict__ BT, const bf16_t* __restrict__ CN,
                   const float* __restrict__ TE, const float* __restrict__ TW, const float* __restrict__ ATOT, const float* __restrict__ st_in, float* __restrict__ st_out,
                   bf16_t* __restrict__ Y, unsigned char* lds, int tid) {
    asm volatile("" : "+v"(tid));
    const int lane = tid & 63, wv = tid >> 6, r = lane & 31, hh = lane >> 5, hq = wv >> 1, pt = wv & 1, head = g * 4 + hq, col = dir * 32 + head;
    const int T0 = seq < 16 ? seq * 256 : 4096 + (seq - 16) * 1024, nc = seq < 16 ? 2 : 8;
    f32x16 H[4];
    if (seq < 16) {
#pragma unroll
        for (int nt = 0; nt < 4; ++nt) H[nt] = zero16();
    } else {
        const float* sp = st_in + ((size_t)((seq - 16) * 32 + head) * 64) * 128;
#pragma unroll
        for (int nt = 0; nt < 4; ++nt)
#pragma unroll
            for (int g4 = 0; g4 < 4; ++g4) { const f32x4 v = *(const f32x4*)(sp + (size_t)(pt * 32 + r) * 128 + nt * 32 + 8 * g4 + 4 * hh);
                H[nt][4 * g4] = v[0]; H[nt][4 * g4 + 1] = v[1]; H[nt][4 * g4 + 2] = v[2]; H[nt][4 * g4 + 3] = v[3]; }
    }
    const bf16_t* xrow = XT + (size_t)(head * 64 + pt * 32 + r) * 8192;
    const int srow = tid >> 4, sc16 = tid & 15;
    const int tcol = dir * 32 + g * 4 + (tid >> 7), ts = tid & 127;
    u32x4 pC[4], pB[4]; float pte, ptw;
#define SB_STAGE_LOAD(t0_) do { const int t0s = (t0_); _Pragma("unroll") for (int i = 0; i < 4; ++i) { \
        pC[i] = *(const u32x4*)(CN + (size_t)(t0s + srow + 32 * i) * 1024 + g * 128 + sc16 * 8); \
        pB[i] = *(const u32x4*)(BT + (size_t)(g * 128 + srow + 32 * i) * 8192 + t0s + sc16 * 8); } \
        pte = TE[(size_t)tcol * 8192 + t0s + ts]; ptw = TW[(size_t)tcol * 8192 + t0s + ts]; } while (0)
#define SB_STAGE_STORE(L) do { _Pragma("unroll") for (int i = 0; i < 4; ++i) { unsigned char* c_ = (L) + SB_C + (srow + 32 * i) * 272 + (sc16 >> 1) * 32 + (sc16 & 1) * 8; \
        *(u32x2*)c_ = (u32x2){pC[i][0], pC[i][1]}; *(u32x2*)(c_ + 16) = (u32x2){pC[i][2], pC[i][3]}; \
        *(u32x4*)((L) + SB_BT + (srow + 32 * i) * 272 + sc16 * 16) = pB[i]; } \
        ((float*)((L) + SB_TE))[tid] = pte; ((float*)((L) + SB_TW))[tid] = ptw; } while (0)
    SB_STAGE_LOAD(T0 + (dir ? nc - 1 : 0) * 128); SB_STAGE_STORE(lds);
    SB_STAGE_LOAD(T0 + (dir ? nc - 2 : 1) * 128);
    __syncthreads();
#pragma unroll 1
    for (int cc = 0; cc < nc; ++cc) {
        const int c = dir ? nc - 1 - cc : cc, t0 = T0 + c * 128;
        unsigned char* const LB = lds + (cc & 1) * SB_BUF;
        u32x4 xr[8];
#pragma unroll
        for (int ks = 0; ks < 8; ++ks) xr[ks] = *(const u32x4*)(xrow + t0 + ks * 16 + hh * 8);
        const float at = ATOT[(t0 >> 7) * 64 + col];
        __builtin_amdgcn_sched_barrier(0);
        if (cc + 1 < nc) SB_STAGE_STORE(lds + ((cc + 1) & 1) * SB_BUF);
        if (cc + 2 < nc) SB_STAGE_LOAD(T0 + (dir ? nc - 3 - cc : cc + 2) * 128);
        __builtin_amdgcn_sched_barrier(0);
        {
            bf16x8 hp[4][2];
#pragma unroll
            for (int nt = 0; nt < 4; ++nt) { hp[nt][0] = pack8<0>(H[nt]); hp[nt][1] = pack8<1>(H[nt]); }
#pragma unroll
            for (int lt = 0; lt < 4; ++lt) {
                const unsigned char* cp = LB + SB_C + (lt * 32 + r) * 272 + 16 * hh;
                bf16x8 cq[4][2];
#pragma unroll
                for (int nt = 0; nt < 4; ++nt) { cq[nt][0] = *(const bf16x8*)(cp + nt * 64); cq[nt][1] = *(const bf16x8*)(cp + nt * 64 + 32); }
                const float ev = *(const float*)(LB + SB_TE + (hq * 128 + lt * 32 + r) * 4);
                __builtin_amdgcn_sched_barrier(0);
                f32x16 y = zero16();
#pragma unroll
                for (int nt = 0; nt < 4; ++nt) {
                    y = MFMA32(hp[nt][0], cq[nt][0], y); y = MFMA32(hp[nt][1], cq[nt][1], y); }
                store_yT_wide(y, ev, Y + (size_t)(t0 + lt * 32 + r) * 2048 + head * 64 + pt * 32, hh);
            }
        }
#pragma unroll
        for (int nt = 0; nt < 4; ++nt) H[nt] *= at;
#pragma unroll
        for (int kb = 0; kb < 4; ++kb) {
            f32x4 w0[2], w1[2]; bf16x8 bfr[2][4];
#pragma unroll
            for (int k2 = 0; k2 < 2; ++k2) { const int ks = kb * 2 + k2;
                w0[k2] = *(const f32x4*)(LB + SB_TW + (hq * 128 + ks * 16 + hh * 8) * 4); w1[k2] = *(const f32x4*)(LB + SB_TW + (hq * 128 + ks * 16 + hh * 8 + 4) * 4);
#pragma unroll
                for (int nt = 0; nt < 4; ++nt) bfr[k2][nt] = *(const bf16x8*)(LB + SB_BT + (nt * 32 + r) * 272 + ks * 32 + hh * 16); }
            __builtin_amdgcn_sched_barrier(0);
#pragma unroll
            for (int k2 = 0; k2 < 2; ++k2) { const int ks = kb * 2 + k2;
                u32x4 xs; xs[0] = pk2(bflo(xr[ks][0]) * w0[k2][0], bfhi(xr[ks][0]) * w0[k2][1]); xs[1] = pk2(bflo(xr[ks][1]) * w0[k2][2], bfhi(xr[ks][1]) * w0[k2][3]);
                xs[2] = pk2(bflo(xr[ks][2]) * w1[k2][0], bfhi(xr[ks][2]) * w1[k2][1]); xs[3] = pk2(bflo(xr[ks][3]) * w1[k2][2], bfhi(xr[ks][3]) * w1[k2][3]);
                const bf16x8 xf = __builtin_bit_cast(bf16x8, xs);
#pragma unroll
                for (int nt = 0; nt < 4; ++nt) H[nt] = MFMA32(bfr[k2][nt], xf, H[nt]); }
        }
        __syncthreads();
    }
    if (seq < 16) {
        float* sp = st_out + ((size_t)(seq * 32 + head) * 64) * 128;
#pragma unroll
        for (int nt = 0; nt < 4; ++nt)
#pragma unroll
            for (int g4 = 0; g4 < 4; ++g4) { f32x4 v; v[0] = H[nt][4 * g4]; v[1] = H[nt][4 * g4 + 1]; v[2] = H[nt][4 * g4 + 2]; v[3] = H[nt][4 * g4 + 3];
                *(f32x4*)(sp + (size_t)(pt * 32 + r) * 128 + nt * 32 + 8 * g4 + 4 * hh) = v; }
    }
}

constexpr int DB_BN = 0, DB_CN = 34816, DB_XT = 69632, DB_TAB = 139264;
DI void diag_block(int sc, int g, const bf16_t* __restrict__ XT, const bf16_t* __restrict__ BN, const bf16_t* __restrict__ CN,
                   const float* __restrict__ CUM, const float* __restrict__ DTT, const float* __restrict__ Dskip, bf16_t* __restrict__ Y, unsigned char* lds, int tid) {
    asm volatile("" : "+v"(tid));
    const int lane = tid & 63, wv = __builtin_amdgcn_readfirstlane(tid >> 6), r = lane & 31, hh = lane >> 5, lt = wv & 3, hp2 = wv >> 2, t0 = sc * 128, l = lt * 32 + r;
    {
        const int srow = tid >> 4, sc16 = tid & 15;
        u32x4 a[4], b[4], x[8]; float tb[4];
#pragma unroll
        for (int i = 0; i < 4; ++i) { a[i] = *(const u32x4*)(BN + (size_t)(t0 + srow + 32 * i) * 1024 + g * 128 + sc16 * 8); b[i] = *(const u32x4*)(CN + (size_t)(t0 + srow + 32 * i) * 1024 + g * 128 + sc16 * 8); }
#pragma unroll
        for (int i = 0; i < 8; ++i) x[i] = *(const u32x4*)(XT + (size_t)(g * 256 + srow + 32 * i) * 8192 + t0 + sc16 * 8);
#pragma unroll
        for (int i = 0; i < 4; ++i) { const int id = tid + 512 * i, tbl = id >> 9, hq = (id >> 7) & 3, s = id & 127;
            tb[i] = ((tbl & 2) ? DTT : CUM)[(size_t)((tbl & 1) * 32 + g * 4 + hq) * 8192 + t0 + s]; }
#pragma unroll
        for (int i = 0; i < 4; ++i) { *(u32x4*)(lds + DB_BN + (srow + 32 * i) * 272 + sc16 * 16) = a[i]; *(u32x4*)(lds + DB_CN + (srow + 32 * i) * 272 + sc16 * 16) = b[i]; }
#pragma unroll
        for (int i = 0; i < 8; ++i) { unsigned char* q = lds + DB_XT + (srow + 32 * i) * 272 + (sc16 >> 1) * 32 + (sc16 & 1) * 8; *(u32x2*)q = (u32x2){x[i][0], x[i][1]}; *(u32x2*)(q + 16) = (u32x2){x[i][2], x[i][3]}; }
#pragma unroll
        for (int i = 0; i < 4; ++i) ((float*)(lds + DB_TAB))[tid + 512 * i] = tb[i];
    }
    __syncthreads();
    const float* tab = (const float*)(lds + DB_TAB);
    const float dsk0 = Dskip[g * 4 + hp2 * 2], dsk1 = Dskip[g * 4 + hp2 * 2 + 1];
    bf16x8 cf[8];
#pragma unroll
    for (int ks = 0; ks < 8; ++ks) cf[ks] = *(const bf16x8*)(lds + DB_CN + l * 272 + ks * 32 + hh * 16);
    f32x16 y[2][2];
#pragma unroll
    for (int a = 0; a < 2; ++a) { y[a][0] = zero16(); y[a][1] = zero16(); }
    float cfl[2], rbl[2], dsum[2];
#pragma unroll
    for (int a = 0; a < 2; ++a) { const int hq = hp2 * 2 + a; cfl[a] = tab[hq * 128 + l]; rbl[a] = tab[512 + hq * 128 + l]; dsum[a] = tab[1024 + hq * 128 + l] + tab[1536 + hq * 128 + l]; }
#pragma unroll 1
    for (int st = 0; st < 4; ++st) {
        bf16x8 bq[8];
#pragma unroll
        for (int ks = 0; ks < 8; ++ks) bq[ks] = *(const bf16x8*)(lds + DB_BN + (st * 32 + r) * 272 + ks * 32 + hh * 16);
        __builtin_amdgcn_sched_barrier(0);
        f32x16 x = zero16();
#pragma unroll
        for (int ks = 0; ks < 8; ++ks) x = MFMA32(bq[ks], cf[ks], x);
#pragma unroll
        for (int a = 0; a < 2; ++a) { const int hq = hp2 * 2 + a;
            f32x16 xs;
#pragma unroll
            for (int g4 = 0; g4 < 4; ++g4) { const int s0 = st * 32 + 8 * g4 + 4 * hh;
                const f32x4 cfs = *(const f32x4*)(tab + hq * 128 + s0), rbs = *(const f32x4*)(tab + 512 + hq * 128 + s0), dfs = *(const f32x4*)(tab + 1024 + hq * 128 + s0), dbs = *(const f32x4*)(tab + 1536 + hq * 128 + s0);
                if (st == lt) {
#pragma unroll
                    for (int j = 0; j < 4; ++j) { const int sI = s0 + j; const bool lo = sI < l, eq = sI == l;
                        const float arg = lo ? cfl[a] - cfs[j] : rbl[a] - rbs[j];
                        const float e = __expf(fminf(arg, 0.f));
                        const float val = eq ? dsum[a] : e * (lo ? dfs[j] : dbs[j]);
                        xs[4 * g4 + j] = x[4 * g4 + j] * val + (eq ? (a ? dsk1 : dsk0) : 0.f); }
                } else {
                    const bool lo = st < lt;
#pragma unroll
                    for (int j = 0; j < 4; ++j) { const float arg = lo ? cfl[a] - cfs[j] : rbl[a] - rbs[j];
                        xs[4 * g4 + j] = x[4 * g4 + j] * (__expf(fminf(arg, 0.f)) * (lo ? dfs[j] : dbs[j])); }
                } }
            const bf16x8 m0 = pack8<0>(xs), m1 = pack8<1>(xs);
#pragma unroll
            for (int pt = 0; pt < 2; ++pt) { const unsigned char* q = lds + DB_XT + (hq * 64 + pt * 32 + r) * 272 + st * 64 + 16 * hh;
                y[a][pt] = MFMA32(*(const bf16x8*)q, m0, y[a][pt]); y[a][pt] = MFMA32(*(const bf16x8*)(q + 32), m1, y[a][pt]); }
        }
    }
#pragma unroll
    for (int a = 0; a < 2; ++a) { const int head = g * 4 + hp2 * 2 + a;
#pragma unroll
        for (int pt = 0; pt < 2; ++pt) store_yT_wide(y[a][pt], 1.0f, Y + (size_t)(t0 + l) * 2048 + head * 64 + pt * 32, hh); }
    __syncthreads();
}

DI void conv_load(int u, const bf16_t* __restrict__ XBC, const float* __restrict__ cwin, const float* __restrict__ cbin, int tid, u32x4 (&pv)[3], float (&cv)[6]) {
    const int tb = u >> 5, cb = u & 31, T0 = tb * 64, ch0 = cb * 128;
    { const float* cw = cwin + ch0 + (tid & 127); cv[0] = cw[0]; cv[1] = cw[4096]; cv[2] = cw[2 * 4096]; cv[3] = cw[3 * 4096]; cv[4] = cw[4 * 4096]; cv[5] = cbin[ch0 + (tid & 127)]; }
    const int s0 = T0 < 4096 ? (T0 & ~255) : 4096 + ((T0 - 4096) & ~1023), s1 = s0 + (T0 < 4096 ? 256 : 1024);
#pragma unroll
    for (int i = 0; i < 3; ++i) { const int idx = tid + NTHR * i, rr = idx >> 4, c8 = idx & 15, T = T0 - 2 + rr; u32x4 w = {0u, 0u, 0u, 0u};
        if (idx < 68 * 16 && T >= s0 && T < s1) w = *(const u32x4*)(XBC + (size_t)T * 4096 + ch0 + c8 * 8);
        pv[i] = w; }
}
DI void conv_unit(int u, int unext, const bf16_t* __restrict__ XBC, const float* __restrict__ cwin, const float* __restrict__ cbin, bf16_t* __restrict__ XT, bf16_t* __restrict__ BT, bf16_t* __restrict__ BN, bf16_t* __restrict__ CN,
                  bf16_t* Li, bf16_t* Lo, int tid, const u32x4 (&pre)[3], const float (&cwv)[6], u32x4 (&pnext)[3], float (&cnext)[6]) {
    const int tb = u >> 5, cb = u & 31, T0 = tb * 64, ch0 = cb * 128;
#pragma unroll
            for (int i = 0; i < 3; ++i) { const int idx = tid + NTHR * i, rr = idx >> 4, c8 = idx & 15; if (idx < 68 * 16) *(u32x4*)(Li + rr * 136 + c8 * 8) = pre[i]; }
            const float w0 = cwv[0], w1 = cwv[1], w2 = cwv[2], w3 = cwv[3], w4 = cwv[4], bias = cwv[5];
            if (unext < 4096) conv_load(unext, XBC, cwin, cbin, tid, pnext, cnext);
            __syncthreads();
            { const int ch = tid & 127, tg = tid >> 7;
              float x0 = __uint_as_float((unsigned)Li[(tg * 16 + 0) * 136 + ch] << 16), x1 = __uint_as_float((unsigned)Li[(tg * 16 + 1) * 136 + ch] << 16),
                    x2 = __uint_as_float((unsigned)Li[(tg * 16 + 2) * 136 + ch] << 16), x3 = __uint_as_float((unsigned)Li[(tg * 16 + 3) * 136 + ch] << 16);
#pragma unroll
              for (int j = 0; j < 16; ++j) { const float x4 = __uint_as_float((unsigned)Li[(tg * 16 + j + 4) * 136 + ch] << 16);
                  const float y = bias + w0 * x0 + w1 * x1 + w2 * x2 + w3 * x3 + w4 * x4;
                  Lo[(tg * 16 + j) * 136 + ch] = (bf16_t)(pk2(silu(y), 0.f) & 0xffffu);
                  x0 = x1; x1 = x2; x2 = x3; x3 = x4; } }
            __syncthreads();
            if (cb < 24) {
                bf16_t* dst = cb < 16 ? XT + (size_t)ch0 * 8192 + T0 : BT + (size_t)(ch0 - 2048) * 8192 + T0;
                const int ch = tid & 127, tq = tid >> 7; u32x4 a0, a1;
#pragma unroll
                for (int j = 0; j < 4; ++j) { a0[j] = (unsigned)Lo[(tq * 16 + 2 * j) * 136 + ch] | ((unsigned)Lo[(tq * 16 + 2 * j + 1) * 136 + ch] << 16);
                                              a1[j] = (unsigned)Lo[(tq * 16 + 8 + 2 * j) * 136 + ch] | ((unsigned)Lo[(tq * 16 + 8 + 2 * j + 1) * 136 + ch] << 16); }
                bf16_t* dp = dst + (size_t)ch * 8192 + tq * 16; *(u32x4*)dp = a0; *(u32x4*)(dp + 8) = a1;
            }
            if (cb >= 16) {
                bf16_t* dst = cb < 24 ? BN + (ch0 - 2048) : CN + (ch0 - 3072);
#pragma unroll
                for (int i = 0; i < 2; ++i) { const int idx = tid + NTHR * i, rr = idx >> 4, c8 = idx & 15; *(u32x4*)(dst + (size_t)(T0 + rr) * 1024 + c8 * 8) = *(const u32x4*)(Lo + rr * 136 + c8 * 8); }
            }
}

__global__ void __launch_bounds__(NTHR, 2) mega(Params P) {
    extern __shared__ __attribute__((aligned(16))) unsigned char lds[];
    cg::grid_group grid = cg::this_grid();
    const int tid = threadIdx.x, lane = tid & 63, wv = __builtin_amdgcn_readfirstlane(tid >> 6);
    const int G = gridDim.x, bx = blockIdx.x, gw = bx * 8 + wv, nw = G * 8;
    unsigned char* ws = P.ws;
    float* MOD = (float*)(ws + WS_MOD); float* ATOT = (float*)(ws + WS_ATOT);
    float* out = P.out;
    PG8_LAS unsigned char* ldsg = (PG8_LAS unsigned char*)lds;
    unsigned* xbar = (unsigned*)(ws + WS_XBAR);
    volatile LAS unsigned* xst = (volatile LAS unsigned*)(ldsg + 153536 + 16);
    if (tid == 0) { xst[0] = 0u; xst[1] = 0u; }
    __syncthreads();
    XcdBarrier xb = xcd_barrier_post(xbar, xst);
    if (P.ws == nullptr) grid.sync();
#define GRID_BAR() xcd_barrier(xb)

    for (int rep_ = 0; rep_ <= (int)((REPMASK >> 0) & 1u); ++rep_) if (rep_ == 0 || (GRID_BAR(), true))
    {
    if (bx < 192) {
        float* s = (float*)lds;
        for (int i = tid; i < 5 * 1024; i += NTHR) { const int m = i >> 10, k = i & 1023; const float v = (m == 0) ? P.in[7][k] : P.in[2][(m - 1) * 1024 + k]; s[i] = silu(v); }
        __syncthreads();
        const int c4 = tid & 7, kg = tid >> 3, col = bx * 32 + c4 * 4;
        float a[5][4];
#pragma unroll
        for (int m = 0; m < 5; ++m) { a[m][0] = 0.f; a[m][1] = 0.f; a[m][2] = 0.f; a[m][3] = 0.f; }
        const float* wa = P.in[10] + col;
#pragma unroll 4
        for (int i = 0; i < 16; ++i) { const int k = kg + 64 * i; const f32x4 w = *(const f32x4*)(wa + (size_t)k * 6144);
#pragma unroll
            for (int m = 0; m < 5; ++m) { const float sv = s[m * 1024 + k]; a[m][0] += sv * w[0]; a[m][1] += sv * w[1]; a[m][2] += sv * w[2]; a[m][3] += sv * w[3]; } }
        float* red = s + 5120;
#pragma unroll
        for (int m = 0; m < 5; ++m) { f32x4 v; v[0] = a[m][0]; v[1] = a[m][1]; v[2] = a[m][2]; v[3] = a[m][3]; *(f32x4*)(red + (kg * 5 + m) * 32 + c4 * 4) = v; }
        __syncthreads();
        if (tid < 160) { const int m = tid >> 5, cl = tid & 31; float t = 0.f; for (int q = 0; q < 64; ++q) t += red[(q * 5 + m) * 32 + cl]; MOD[m * 6144 + bx * 32 + cl] = t + P.in[11][m * 0 + bx * 32 + cl]; }
        __syncthreads();
    }
    wconv_loop<0>(P.in, ws, 180 * 16, bx, G, lds, tid);
    }
    GRID_BAR();
    for (int rep_ = 0; rep_ <= (int)((REPMASK >> 1) & 1u); ++rep_) if (rep_ == 0 || (GRID_BAR(), true))
    norm_rows(P.in[0], P.in[1], P.in[8], MOD, 0, 1024, (bf16_t*)(ws + WS_HB), gw, nw, lane);
    GRID_BAR();
    for (int rep_ = 0; rep_ <= (int)((REPMASK >> 2) & 1u); ++rep_) if (rep_ == 0 || (GRID_BAR(), true))
    {
        pg8::Gemm g{(const bf16_t*)(ws + WS_HB), (const bf16_t*)(ws + WS_WIN), TOK, 5376, 1024}; pg8::StaticOrder S; S.init(TOK, 5376, G, bx);
        EpiIn1 E{(bf16_t*)(ws + WS_QK), (bf16_t*)(ws + WS_V), (bf16_t*)(ws + WS_G), (float*)(ws + WS_DT), out + 12582912};
        pg8::gemm_phase2<EpiIn1, pg8::StaticOrder, true, true>(ldsg, g, S, E);
        __syncthreads();
        {
            const int nidle = G == 256 ? 96 : G, me = G == 256 ? bx - 160 : bx;
            if (me >= 0) {
                wconv_loop<1>(P.in, ws, 256, me, nidle, lds, tid);
                wconv_loop<1>(P.in, ws, 1024, 768 + me, nidle, lds, tid);
                bf16_t* KNII = (bf16_t*)(ws + WS_KNII);
                for (int i = me * NTHR + tid; i < 262144; i += nidle * NTHR) { const int e = i * 8, d = e & 63, cc = (e >> 6) & 1, hd = (e >> 7) & 7, pq = (e >> 10) & 511, b = e >> 19;
                    const f32x4 a = *(const f32x4*)(P.in[3] + e), c2 = *(const f32x4*)(P.in[3] + e + 4);
                    u32x4 w; w[0] = pk2(a[0], a[1]); w[1] = pk2(a[2], a[3]); w[2] = pk2(c2[0], c2[1]); w[3] = pk2(c2[2], c2[3]);
                    *(u32x4*)(KNII + ((size_t)((b * 8 + hd) * 2 + cc) * 1536 + 1024 + pq) * 64 + d) = w; }
            }
        }
    }
    GRID_BAR();
    for (int rep_ = 0; rep_ <= (int)((REPMASK >> 3) & 1u); ++rep_) if (rep_ == 0 || (GRID_BAR(), true))
    {
        const bf16_t* QK = (const bf16_t*)(ws + WS_QK);
        bf16_t* QN = (bf16_t*)(ws + WS_QN); bf16_t* KNI = (bf16_t*)(ws + WS_KNI); bf16_t* KNII = (bf16_t*)(ws + WS_KNII);
        float* nck = out + 8388608;
        float gq[16], gk[16];
#pragma unroll
        for (int e = 0; e < 16; ++e) { gq[e] = P.in[13][(lane & 3) * 16 + e]; gk[e] = P.in[14][(lane & 3) * 16 + e]; }
        for (int T = gw; T < TOK; T += nw) {
            const int pp = (T - 4096) & 1023, sub = lane & 3;
            const float pos = (float)((sub < 2) ? (pp >> 6) : (pp & 63)), sgn = (lane & 1) ? 1.0f : -1.0f;
            u32x4 rq[2][2];
#pragma unroll
            for (int qk = 0; qk < 2; ++qk) { rq[qk][0] = *(const u32x4*)(QK + (size_t)T * 2048 + qk * 1024 + lane * 16); rq[qk][1] = *(const u32x4*)(QK + (size_t)T * 2048 + qk * 1024 + lane * 16 + 8); }
#pragma unroll
            for (int qk = 0; qk < 2; ++qk) {
                const u32x4 r0 = rq[qk][0], r1 = rq[qk][1];
                float v[16];
#pragma unroll
                for (int j = 0; j < 4; ++j) { v[2 * j] = bflo(r0[j]); v[2 * j + 1] = bfhi(r0[j]); v[8 + 2 * j] = bflo(r1[j]); v[8 + 2 * j + 1] = bfhi(r1[j]); }
                float ss = 0.f;
#pragma unroll
                for (int e = 0; e < 16; ++e) ss += v[e] * v[e];
                ss += __shfl_xor(ss, 1); ss += __shfl_xor(ss, 2);
                const float rs = rsqrtf(ss * (1.0f / 64.0f) + EPSF);
#pragma unroll
                for (int e = 0; e < 16; ++e) v[e] = v[e] * rs * (qk ? gk[e] : gq[e]);
                if (qk == 1 && T < 4096) {
#pragma unroll
                    for (int i = 0; i < 4; ++i) { f32x4 o; o[0] = v[4 * i]; o[1] = v[4 * i + 1]; o[2] = v[4 * i + 2]; o[3] = v[4 * i + 3]; *(f32x4*)(nck + (size_t)T * 1024 + lane * 16 + 4 * i) = o; }
                }
                if (T >= 4096) {
#pragma unroll
                    for (int e = 0; e < 16; ++e) { const float pr = __shfl_xor(v[e], 1);
                        const float inv = __builtin_amdgcn_exp2f(-(float)e * (13.287712379549449f / 16.0f));
                        const float ang = pos * inv; const float sn = __sinf(ang), cs = __cosf(ang);
                        v[e] = v[e] * cs + sgn * pr * sn; }
                }
                if (qk == 0) {
#pragma unroll
                    for (int e = 0; e < 16; ++e) v[e] *= 0.125f * 1.4426950408889634f;
                }
                u32x4 w0, w1;
#pragma unroll
                for (int j = 0; j < 4; ++j) { w0[j] = pk2(v[2 * j], v[2 * j + 1]); w1[j] = pk2(v[8 + 2 * j], v[8 + 2 * j + 1]); }
                const int hd = lane >> 3, cc = (lane >> 2) & 1, d0 = sub * 16;
                bf16_t* dp;
                if (qk == 0) dp = QN + ((size_t)(hd * 2 + cc) * 8192 + T) * 64 + d0;
                else if (T < 4096) dp = KNI + ((size_t)(hd * 2 + cc) * 4096 + T) * 64 + d0;
                else dp = KNII + ((size_t)((((T - 4096) >> 10) * 8 + hd) * 2 + cc) * 1536 + pp) * 64 + d0;
                *(u32x4*)dp = w0; *(u32x4*)(dp + 8) = w1;
            }
        }
        { float* CUM = (float*)(ws + WS_TAB); float* DTT = CUM + TABSZ; float* TE = DTT + TABSZ; float* TW = TE + TABSZ; const float* DT = (const float*)(ws + WS_DT);
          for (int it = gw; it < 4096; it += nw) { const int sc = it >> 6, col = it & 63;
            const float bias = P.in[23][col], A = -__expf(P.in[22][col]);
            const float x0 = DT[(size_t)(sc * 128 + 2 * lane) * 64 + col] + bias, x1 = DT[(size_t)(sc * 128 + 2 * lane + 1) * 64 + col] + bias;
            const float d0 = x0 > 20.f ? x0 : log1pf(__expf(x0)), d1 = x1 > 20.f ? x1 : log1pf(__expf(x1));
            const float a0 = d0 * A, a1 = d1 * A;
            float x = a0 + a1;
#pragma unroll
            for (int o = 1; o < 64; o <<= 1) { const float t = __shfl_up(x, o); if (lane >= o) x += t; }
            const float tot = __shfl(x, 63);
            float c1 = x, c0 = x - a1;
            if (col >= 32) { c0 = tot - c0 + a0; c1 = tot - c1 + a1; }
            const size_t o = (size_t)col * 8192 + sc * 128 + 2 * lane;
            *(f32x2*)(CUM + o) = (f32x2){c0, c1}; *(f32x2*)(DTT + o) = (f32x2){d0, d1};
            *(f32x2*)(TE + o) = (f32x2){__expf(c0), __expf(c1)}; *(f32x2*)(TW + o) = (f32x2){d0 * __expf(tot - c0), d1 * __expf(tot - c1)};
            if (lane == 0) ATOT[sc * 64 + col] = __expf(tot); } }
        { const bf16_t* V = (const bf16_t*)(ws + WS_V); bf16_t* VTI = (bf16_t*)(ws + WS_VTI); bf16_t* VTII = (bf16_t*)(ws + WS_VTII); bf16_t* Ls = (bf16_t*)lds;
          for (int u = bx; u < 1280; u += G) {
            bf16_t* dst; size_t ldd;
            if (u < 1024) { const int tb = u >> 3, hd = u & 7, T0 = tb * 64;
#pragma unroll
                for (int i = 0; i < 2; ++i) { const int idx = tid + NTHR * i, rr = idx >> 4, c8 = idx & 15; *(u32x4*)(Ls + rr * 136 + c8 * 8) = *(const u32x4*)(V + (size_t)(T0 + rr) * 1024 + hd * 128 + c8 * 8); }
                if (T0 < 4096) { dst = VTI + (size_t)hd * 128 * 4096 + T0; ldd = 4096; } else { const int b = (T0 - 4096) >> 10, p0 = (T0 - 4096) & 1023; dst = VTII + (size_t)(b * 8 + hd) * 128 * 1536 + p0; ldd = 1536; }
            } else { const int uu = u - 1024, b = uu >> 6, pb = (uu >> 3) & 7, hd = uu & 7;
#pragma unroll
                for (int i = 0; i < 4; ++i) { const int idx = tid + NTHR * i, rr = idx >> 5, c4 = idx & 31;
                    const f32x4 a = *(const f32x4*)(P.in[4] + ((size_t)((b * 512 + pb * 64 + rr) * 8 + hd)) * 128 + c4 * 4);
                    u32x2 w; w[0] = pk2(a[0], a[1]); w[1] = pk2(a[2], a[3]); *(u32x2*)(Ls + rr * 136 + c4 * 4) = w; }
                dst = VTII + (size_t)(b * 8 + hd) * 128 * 1536 + 1024 + pb * 64; ldd = 1536; }
            __syncthreads();
            { const int vd = tid & 127, tq = tid >> 7; u32x4 w0, w1;
#pragma unroll
              for (int j = 0; j < 4; ++j) { w0[j] = (unsigned)Ls[(tq * 16 + 2 * j) * 136 + vd] | ((unsigned)Ls[(tq * 16 + 2 * j + 1) * 136 + vd] << 16);
                                            w1[j] = (unsigned)Ls[(tq * 16 + 8 + 2 * j) * 136 + vd] | ((unsigned)Ls[(tq * 16 + 8 + 2 * j + 1) * 136 + vd] << 16); }
              bf16_t* dp = dst + (size_t)vd * ldd + tq * 16; *(u32x4*)dp = w0; *(u32x4*)(dp + 8) = w1; }
            __syncthreads();
          } }
    }
    GRID_BAR();
    for (int rep_ = 0; rep_ <= (int)((REPMASK >> 4) & 1u); ++rep_) if (rep_ == 0 || (GRID_BAR(), true))
    {
        const bf16_t* QN = (const bf16_t*)(ws + WS_QN); const bf16_t* KNI = (const bf16_t*)(ws + WS_KNI); const bf16_t* KNII = (const bf16_t*)(ws + WS_KNII);
        const bf16_t* VTI = (const bf16_t*)(ws + WS_VTI); const bf16_t* VTII = (const bf16_t*)(ws + WS_VTII); bf16_t* OATT = (bf16_t*)(ws + WS_OATT);
        const float lam = __expf(wsum(P.in[15][lane] * P.in[16][lane])) - __expf(wsum(P.in[17][lane] * P.in[18][lane])) + 0.2f;
        for (int id0 = bx; id0 < 256; id0 += G) { const int id = ((id0 & 7) * 4 + (id0 >> 6)) * 8 + ((id0 >> 3) & 7);
            const int b = id >> 6, hd = (id >> 3) & 7, qb = id & 7, tok0 = 4096 + b * 1024 + qb * 128;
            attn_unit(QN + ((size_t)(hd * 2) * 8192 + tok0) * 64, QN + ((size_t)(hd * 2 + 1) * 8192 + tok0) * 64,
                      KNII + (size_t)((b * 8 + hd) * 2) * 1536 * 64, KNII + (size_t)((b * 8 + hd) * 2 + 1) * 1536 * 64,
                      VTII + (size_t)(b * 8 + hd) * 128 * 1536, 1536, 1536, OATT + (size_t)tok0 * 1024 + hd * 128, lam, P.in[19], lds, tid); }
        for (int id0 = bx; id0 < 256; id0 += G) { const int id = ((id0 & 7) * 16 + (id0 >> 4)) * 2 + ((id0 >> 3) & 1);
            const int b = id >> 4, hd = (id >> 1) & 7, qb = id & 1, tok0 = b * 256 + qb * 128;
            attn_unit(QN + ((size_t)(hd * 2) * 8192 + tok0) * 64, QN + ((size_t)(hd * 2 + 1) * 8192 + tok0) * 64,
                      KNI + ((size_t)(hd * 2) * 4096 + b * 256) * 64, KNI + ((size_t)(hd * 2 + 1) * 4096 + b * 256) * 64,
                      VTI + (size_t)hd * 128 * 4096 + b * 256, 4096, 256, OATT + (size_t)tok0 * 1024 + hd * 128, lam, P.in[19], lds, tid); }
    }
    GRID_BAR();
    for (int rep_ = 0; rep_ <= (int)((REPMASK >> 5) & 1u); ++rep_) if (rep_ == 0 || (GRID_BAR(), true))
    {
        pg8::Gemm g{(const bf16_t*)(ws + WS_HB), (const bf16_t*)(ws + WS_WIN) + (size_t)5376 * 1024, TOK, 6144, 1024}; pg8::StaticOrder S; S.init(TOK, 6144, G, bx);
        EpiIn2 E{(bf16_t*)(ws + WS_Z), (bf16_t*)(ws + WS_XBC)};
        pg8::gemm_phase2<EpiIn2, pg8::StaticOrder, true, true>(ldsg, g, S, E);
    }
    GRID_BAR();
    for (int rep_ = 0; rep_ <= (int)((REPMASK >> 6) & 1u); ++rep_) if (rep_ == 0 || (GRID_BAR(), true))
    {
        const bf16_t* XBC = (const bf16_t*)(ws + WS_XBC); bf16_t* XT = (bf16_t*)out; bf16_t* BT = (bf16_t*)(ws + WS_BT); bf16_t* BN = (bf16_t*)(ws + WS_BN); bf16_t* CN = (bf16_t*)(ws + WS_CN);
        bf16_t* Li = (bf16_t*)lds;
        bf16_t* Lo = Li + 68 * 136;
        const float* cwin = P.in[20]; const float* cbin = P.in[21];
        u32x4 pa[3], pb[3], pc[3]; float ca[6], cbv[6], cc[6];
        if (bx < 4096) conv_load(bx, XBC, cwin, cbin, tid, pa, ca);
        if (bx + G < 4096) conv_load(bx + G, XBC, cwin, cbin, tid, pb, cbv);
        for (int u = bx; u < 4096; u += 3 * G) {
            conv_unit(u, u + 2 * G, XBC, cwin, cbin, XT, BT, BN, CN, Li, Lo, tid, pa, ca, pc, cc);
            if (u + G < 4096) conv_unit(u + G, u + 3 * G, XBC, cwin, cbin, XT, BT, BN, CN, Li, Lo, tid, pb, cbv, pa, ca);
            if (u + 2 * G < 4096) conv_unit(u + 2 * G, u + 4 * G, XBC, cwin, cbin, XT, BT, BN, CN, Li, Lo, tid, pc, cc, pb, cbv);
        }
    }
    GRID_BAR();
    for (int rep_ = 0; rep_ <= (int)((REPMASK >> 7) & 1u); ++rep_) if (rep_ == 0 || (GRID_BAR(), true))
    {
        const bf16_t* XT = (const bf16_t*)out; const bf16_t* BT = (const bf16_t*)(ws + WS_BT); const bf16_t* BN = (const bf16_t*)(ws + WS_BN); const bf16_t* CN = (const bf16_t*)(ws + WS_CN);
        const float* CUM = (const float*)(ws + WS_TAB); const float* DTT = CUM + TABSZ; const float* TE = DTT + TABSZ; const float* TW = TE + TABSZ;
        bf16_t* YD = (bf16_t*)(ws + WS_YD); bf16_t* YF = (bf16_t*)(ws + WS_YF); bf16_t* YB = (bf16_t*)(ws + WS_YB);
        unsigned* gq = (unsigned*)(ws + WS_QCNT); int* slot = (int*)(lds + 153536);
        for (int id = bx; id < 64; id += G)
            scan_block(16 + (id >> 4), (id >> 1) & 7, id & 1, XT, BT, CN, TE, TW, ATOT, (id & 1) ? P.in[6] : P.in[5], out + ((id & 1) ? 20971520 : 16777216), (id & 1) ? YB : YF, lds, tid);
        {
            for (;;) {
                if (tid == 0) *slot = (int)atomicAdd(gq, 1u);
                __syncthreads();
                const int id = *slot;
                __syncthreads();
                if (id >= 768) break;
                if (id < 256) scan_block(id >> 4, (id >> 1) & 7, id & 1, XT, BT, CN, TE, TW, ATOT, (id & 1) ? P.in[6] : P.in[5], out + ((id & 1) ? 20971520 : 16777216), (id & 1) ? YB : YF, lds, tid);
                else diag_block((id - 256) >> 3, (id - 256) & 7, XT, BN, CN, CUM, DTT, P.in[24], YD, lds, tid);
            }
        }
    }
    GRID_BAR();
    for (int rep_ = 0; rep_ <= (int)((REPMASK >> 8) & 1u); ++rep_) if (rep_ == 0 || (GRID_BAR(), true))
    {
        const bf16_t* YD = (const bf16_t*)(ws + WS_YD); const bf16_t* YF = (const bf16_t*)(ws + WS_YF); const bf16_t* YB = (const bf16_t*)(ws + WS_YB); const bf16_t* Z = (const bf16_t*)(ws + WS_Z);
        bf16_t* YG = (bf16_t*)(ws + WS_YG);
        f32x4 gn[8];
#pragma unroll
        for (int i = 0; i < 8; ++i) gn[i] = *(const f32x4*)(P.in[25] + lane * 32 + i * 4);
#pragma unroll 2
        for (int row = gw; row < TOK; row += nw) {
            float u[32]; float ss = 0.f;
#pragma unroll
            for (int i = 0; i < 4; ++i) { const size_t o = (size_t)row * 2048 + lane * 32 + i * 8;
                const u32x4 a = *(const u32x4*)(YD + o), b = *(const u32x4*)(YF + o), c = *(const u32x4*)(YB + o), z = *(const u32x4*)(Z + o);
#pragma unroll
                for (int j = 0; j < 4; ++j) { const float y0 = bflo(a[j]) + bflo(b[j]) + bflo(c[j]), y1 = bfhi(a[j]) + bfhi(b[j]) + bfhi(c[j]);
                    const float t0 = y0 * silu(bflo(z[j])), t1 = y1 * silu(bfhi(z[j])); u[i * 8 + 2 * j] = t0; u[i * 8 + 2 * j + 1] = t1; ss += t0 * t0 + t1 * t1; } }
            ss = wsum(ss);
            const float rstd = rsqrtf(ss * (1.0f / 2048.0f) + EPSF);
#pragma unroll
            for (int i = 0; i < 4; ++i) { const int c = lane * 32 + i * 8; const f32x4 g0 = gn[2 * i], g1 = gn[2 * i + 1];
                u32x4 w; w[0] = pk2(u[i * 8] * rstd * g0[0], u[i * 8 + 1] * rstd * g0[1]); w[1] = pk2(u[i * 8 + 2] * rstd * g0[2], u[i * 8 + 3] * rstd * g0[3]);
                w[2] = pk2(u[i * 8 + 4] * rstd * g1[0], u[i * 8 + 5] * rstd * g1[1]); w[3] = pk2(u[i * 8 + 6] * rstd * g1[2], u[i * 8 + 7] * rstd * g1[3]);
                *(u32x4*)(YG + (size_t)row * 2048 + c) = w; }
        }
        wconv_loop<1>(P.in, ws, 768, 256 + bx, G, lds, tid);
    }
    GRID_BAR();
    for (int rep_ = 0; rep_ <= (int)((REPMASK >> 9) & 1u); ++rep_) if (rep_ == 0 || (GRID_BAR(), true))
    {
        pg8::StaticOrder S; S.init(2 * TOK, 1024, G, bx);
        u32x4 keepb[8];
#pragma unroll
        for (int i = 0; i < 8; ++i) keepb[i] = (u32x4){0u, 0u, 0u, 0u};
        { pg8::Gemm g{(const bf16_t*)(ws + WS_YG), (const bf16_t*)(ws + WS_WB), TOK, 1024, 2048};
          EpiBranch<1, 1> E{(const bf16_t*)(ws + WS_G), (bf16_t*)(ws + WS_MA), keepb};
          pg8::gemm_phase2<EpiBranch<1, 1>, pg8::StaticOrder, true, true, true>(ldsg, g, S, E); }
        __syncthreads();
        { pg8::Gemm g{(const bf16_t*)(ws + WS_OATT), (const bf16_t*)(ws + WS_WA), TOK, 1024, 1024};
          EpiBranch<0, 1> E{(const bf16_t*)(ws + WS_G), (bf16_t*)(ws + WS_MA), keepb};
          pg8::gemm_phase2<EpiBranch<0, 1>, pg8::StaticOrder, true, true, true>(ldsg, g, S, E); }
    }
    GRID_BAR();
    for (int rep_ = 0; rep_ <= (int)((REPMASK >> 10) & 1u); ++rep_) if (rep_ == 0 || (GRID_BAR(), true))
    {
        pg8::Gemm g{(const bf16_t*)(ws + WS_MA), (const bf16_t*)(ws + WS_WOUT), TOK, 1024, 1024}; pg8::StaticOrder S; S.init(2 * TOK, 1024, G, bx);
        EpiRes<0, 1> E{P.in[0], P.in[1], MOD, out};
        pg8::gemm_phase2<EpiRes<0, 1>, pg8::StaticOrder, true, true, true>(ldsg, g, S, E);
    }
    GRID_BAR();
    for (int rep_ = 0; rep_ <= (int)((REPMASK >> 11) & 1u); ++rep_) if (rep_ == 0 || (GRID_BAR(), true))
    { norm_rows(out, out + (size_t)4096 * 1024, P.in[9], MOD, 3072, 4096, (bf16_t*)(ws + WS_H2), gw, nw, lane);
      wconv_loop<2>(P.in, ws, 1408, bx, G, lds, tid); }
    GRID_BAR();
    for (int rep_ = 0; rep_ <= (int)((REPMASK >> 12) & 1u); ++rep_) if (rep_ == 0 || (GRID_BAR(), true))
    {
        pg8::Gemm g{(const bf16_t*)(ws + WS_H2), (const bf16_t*)(ws + WS_WGU), TOK, 5632, 1024}; pg8::StaticOrder S; S.init(TOK, 5632, G, bx);
        EpiUp E{(bf16_t*)(ws + WS_ACT)};
        pg8::gemm_phase2<EpiUp, pg8::StaticOrder, true, true>(ldsg, g, S, E);
        __syncthreads();
        if (G == 256) { if (bx >= 192) wconv_loop<2>(P.in, ws, 2112, 1408 + (bx - 192), 64, lds, tid); }
        else wconv_loop<2>(P.in, ws, 2112, 1408 + bx, G, lds, tid);
    }
    GRID_BAR();
    for (int rep_ = 0; rep_ <= (int)((REPMASK >> 13) & 1u); ++rep_) if (rep_ == 0 || (GRID_BAR(), true))
    {
        pg8::Gemm g{(const bf16_t*)(ws + WS_ACT), (const bf16_t*)(ws + WS_WD), TOK, 1024, 2816}; pg8::StaticOrder S; S.init(2 * TOK, 1024, G, bx);
        EpiRes<1, 1> E{P.in[0], P.in[1], MOD, out};
        pg8::gemm_phase2<EpiRes<1, 1>, pg8::StaticOrder, true, true, true>(ldsg, g, S, E);
    }
}

extern "C" void kernel_launch(void* const* d_in, const int* in_sizes, int n_in, void* d_out, int out_size, void* d_ws, size_t ws_size, hipStream_t stream) {
    static int grid = 0;
    if (grid == 0) {
        int dev = 0, cus = 0, per_cu = 0;
        (void)hipGetDevice(&dev);
        (void)hipDeviceGetAttribute(&cus, hipDeviceAttributeMultiprocessorCount, dev);
        if (hipFuncSetAttribute((const void*)mega, hipFuncAttributeMaxDynamicSharedMemorySize, LDS_BYTES) != hipSuccess) fprintf(stderr, "kernel_launch: hipFuncSetAttribute failed\n");
        if (hipOccupancyMaxActiveBlocksPerMultiprocessor(&per_cu, (const void*)mega, NTHR, LDS_BYTES) != hipSuccess || per_cu < 1) { fprintf(stderr, "kernel_launch: occupancy query says %d blocks/CU\n", per_cu); per_cu = 1; }
        (void)hipGetLastError();
        grid = cus > 256 ? 256 : cus;
        if (ws_size < 256 * MiB) fprintf(stderr, "kernel_launch: workspace too small: %zu\n", ws_size);
    }
    Params p{};
    for (int i = 0; i < 32; ++i) p.in[i] = (const float*)d_in[i];
    p.out = (float*)d_out; p.ws = (unsigned char*)d_ws;
    (void)hipMemsetAsync((unsigned char*)d_ws + WS_XBAR, 0, 262144, stream);
    void* args[] = {&p};
    hipError_t e = hipLaunchCooperativeKernel((const void*)mega, dim3(grid), dim3(NTHR), args, LDS_BYTES, stream);
    if (e != hipSuccess) fprintf(stderr, "kernel_launch: cooperative launch failed: %s (grid %d)\n", hipGetErrorString(e), grid);
}
```

```cpp
#include <hip/hip_runtime.h>
#include <hip/hip_cooperative_groups.h>
#include <cstdio>
namespace cg = cooperative_groups;

#define DI __device__ __forceinline__
typedef unsigned short bf16_t;
typedef short bf16x8 __attribute__((ext_vector_type(8)));
typedef short s16x4 __attribute__((ext_vector_type(4)));
typedef float f32x4 __attribute__((ext_vector_type(4)));
typedef float f32x2 __attribute__((ext_vector_type(2)));
typedef float f32x16 __attribute__((ext_vector_type(16)));
typedef unsigned u32x4 __attribute__((ext_vector_type(4)));
typedef unsigned u32x2 __attribute__((ext_vector_type(2)));
typedef __bf16 bf16v2 __attribute__((ext_vector_type(2)));

DI unsigned pk2(float a, float b) { f32x2 v = {a, b}; bf16v2 r = __builtin_convertvector(v, bf16v2); return __builtin_bit_cast(unsigned, r); }
DI float bflo(unsigned u) { return __uint_as_float(u << 16); }
DI float bfhi(unsigned u) { return __uint_as_float(u & 0xffff0000u); }
DI float sigm(float x) { return __builtin_amdgcn_rcpf(1.0f + __builtin_amdgcn_exp2f(-1.4426950408889634f * x)); }
DI float silu(float x) { return x * sigm(x); }
#define MFMA32(a, b, c) __builtin_amdgcn_mfma_f32_32x32x16_bf16((a), (b), (c), 0, 0, 0)
DI f32x16 zero16() { f32x16 z; _Pragma("unroll") for (int i = 0; i < 16; ++i) z[i] = 0.f; return z; }
template <int S> DI bf16x8 pack8(const f32x16& x) {
    u32x4 p; p[0] = pk2(x[8 * S], x[8 * S + 1]); p[1] = pk2(x[8 * S + 2], x[8 * S + 3]); p[2] = pk2(x[8 * S + 4], x[8 * S + 5]); p[3] = pk2(x[8 * S + 6], x[8 * S + 7]);
    return __builtin_bit_cast(bf16x8, p);
}
DI bf16x8 cat4(s16x4 a, s16x4 b) { return __builtin_shufflevector(a, b, 0, 1, 2, 3, 4, 5, 6, 7); }
DI float shx(float v, int mask) { int ln = (int)__lane_id(); asm volatile("" : "+v"(ln)); return __uint_as_float((unsigned)__builtin_amdgcn_ds_bpermute((ln ^ mask) << 2, (int)__float_as_uint(v))); }
DI float wsum(float v) { int ln = (int)__lane_id(); asm volatile("" : "+v"(ln)); _Pragma("unroll") for (int o = 32; o >= 1; o >>= 1) v += __uint_as_float((unsigned)__builtin_amdgcn_ds_bpermute((ln ^ o) << 2, (int)__float_as_uint(v))); return v; }

#define XB_TMO      128
#define XB_XCNT(j)  (256  + 64 * (j))
#define XB_XSUB(j)  (1280 + 64 * (j))
#define XB_XGEN(j)  (2304 + 64 * (j))
#define XB_TOP      3328
#define XB_TOPGEN   3392
#define XCD_BAR_WORDS 3456
#define XB_SPIN_CAP (1u << 18)
#define LAS __attribute__((address_space(3)))

__device__ __forceinline__ unsigned xb_ld(unsigned* p)              { return __hip_atomic_load(p, __ATOMIC_RELAXED, __HIP_MEMORY_SCOPE_AGENT); }
__device__ __forceinline__ unsigned xb_add(unsigned* p, unsigned v) { return __hip_atomic_fetch_add(p, v, __ATOMIC_RELAXED, __HIP_MEMORY_SCOPE_AGENT); }
__device__ __forceinline__ unsigned xb_xcc_id() { return (unsigned)__builtin_amdgcn_s_getreg((3 << 11) | 20) & 0xFu; }
#define XB_SPIN(cond, bar) do { unsigned _sp = 0; while (cond) { __builtin_amdgcn_s_sleep(1); \
    if ((++_sp & 255u) == 0u) { if (xb_ld(&(bar)[XB_TMO])) break; if (_sp > XB_SPIN_CAP) { atomicAdd(&(bar)[XB_TMO], 1u); break; } } } } while (0)

struct XcdBarrier {
    unsigned* bar; unsigned x;
    volatile LAS unsigned* st;
};

__device__ __forceinline__ XcdBarrier xcd_barrier_post(unsigned* bar, volatile LAS unsigned* st) {
    XcdBarrier b; b.bar = bar; b.x = xb_xcc_id(); b.st = st;
    if (threadIdx.x == 0) (void)xb_add(&bar[XB_XCNT(b.x)], 1u);
    return b;
}
__device__ __forceinline__ void xcd_barrier_complete(unsigned* bar, unsigned x, unsigned& nloc, unsigned& nx) {
    const unsigned G = gridDim.x * gridDim.y * gridDim.z;
    unsigned sum, cnt, mine, sp = 0u;
    for (;;) {
        sum = 0u; cnt = 0u; mine = 0u;
#pragma unroll
        for (unsigned j = 0; j < 16; ++j) { const unsigned c = xb_ld(&bar[XB_XCNT(j)]); sum += c; cnt += (c > 0u) ? 1u : 0u; mine = (j == x) ? c : mine; }
        if (sum == G) break;
        __builtin_amdgcn_s_sleep(1);
        if ((++sp & 255u) == 0u) { if (xb_ld(&bar[XB_TMO])) break; if (sp > XB_SPIN_CAP) { atomicAdd(&bar[XB_TMO], 1u); break; } }
    }
    nloc = mine > 0u ? mine : 1u; nx = cnt > 0u ? cnt : 1u;
}

__device__ __forceinline__ void xcd_barrier(const XcdBarrier& b) {
    asm volatile("s_waitcnt vmcnt(0)" ::: "memory");
    __syncthreads();
    if (threadIdx.x == 0) {
        unsigned* bar = b.bar;
        __builtin_amdgcn_s_waitcnt(0);
        unsigned nloc = b.st[0], nx = b.st[1];
        if (nloc == 0u) { xcd_barrier_complete(bar, b.x, nloc, nx); b.st[0] = nloc; b.st[1] = nx; }
        const unsigned old = xb_add(&bar[XB_XSUB(b.x)], 1u);
        const unsigned gen = old / nloc;
        if (old + 1u == (gen + 1u) * nloc) {
            __builtin_amdgcn_fence(__ATOMIC_RELEASE, "agent");
            asm volatile("s_waitcnt vmcnt(0)" ::: "memory");
            const unsigned og = xb_add(&bar[XB_TOP], 1u);
            const unsigned tg = og / nx;
            if (og + 1u == (tg + 1u) * nx) xb_add(&bar[XB_TOPGEN], 1u);
            else XB_SPIN(xb_ld(&bar[XB_TOPGEN]) == tg, bar);
            __builtin_amdgcn_fence(__ATOMIC_ACQUIRE, "agent");
            xb_add(&bar[XB_XGEN(b.x)], 1u);
            asm volatile("s_waitcnt vmcnt(0)" ::: "memory");
        } else {
            XB_SPIN(xb_ld(&bar[XB_XGEN(b.x)]) == gen, bar);
            __builtin_amdgcn_fence(__ATOMIC_ACQUIRE, "agent");
            asm volatile("s_waitcnt vmcnt(0)" ::: "memory");
        }
    }
    __syncthreads();
}

namespace pg8 {
#define PG8_LAS __attribute__((address_space(3)))
typedef unsigned short bf16_t;
typedef short bf16x8 __attribute__((ext_vector_type(8)));
typedef float f32x4 __attribute__((ext_vector_type(4)));
typedef unsigned u32x4 __attribute__((ext_vector_type(4)));
constexpr int BM = 256, BK = 64, HALF = 128, HTB = HALF * BK * 2  , STAGE_BYTES = 8 * HTB, NXCD = 8, WGM = 8;

__host__ __device__ __forceinline__ int lds_byte(int r, int c) { const int st = (r >> 4) * 2 + (c >> 5), rr = r & 15, cc = c & 31, ob = rr * 64 + cc * 2; return st * 1024 + (ob ^ (((ob >> 9) & 1) << 5)); }
__host__ __device__ __forceinline__ void stage_rc(int b, int& R, int& C) { const int st = b / 1024, sb = b % 1024, swz = sb ^ (((sb >> 9) & 1) << 5); R = (st >> 1) * 16 + swz / 64; C = (st & 1) * 32 + (swz % 64) / 2; }
__host__ __device__ __forceinline__ int perm32(int rho) { const int n = rho >> 4, i = rho & 15; return 8 * (i >> 2) + 4 * n + (i & 3); }

struct Unit { int pm, pn; };
struct Gemm { const bf16_t* A; const bf16_t* Bt; int M, N, K; };

struct StaticOrder {
    int nM, nN, nwg, G, c;
    __host__ __device__ void init(int M, int N, int G_, int c_) { nM = M / BM; nN = N / BM; nwg = nM * nN; G = G_; c = c_; }
    __host__ __device__ bool next(int i, Unit& u) const {
        const long L = (long)i * G + c; if (L >= nwg) return false;
        int wgid = (int)L; { const int q = nwg / NXCD, r = nwg % NXCD, xcd = wgid % NXCD, off = wgid / NXCD; wgid = (xcd < r ? xcd * (q + 1) : r * (q + 1) + (xcd - r) * q) + off; }
        const int nig = WGM * nN, gid = wgid / nig, fm = gid * WGM, gsz = (nM - fm) < WGM ? (nM - fm) : WGM;
        u.pm = fm + ((wgid % nig) % gsz); u.pn = (wgid % nig) / gsz; return true;
    }
    __device__ __forceinline__ void a_ready(const Unit&) const {}
    __device__ __forceinline__ void done(const Unit&) const {}
};
template <class Epi, class Sched, bool STAMP = false, bool HALFM = false>
__device__ __forceinline__ void gemm_phase(PG8_LAS unsigned char* lds, const Gemm g, const Sched& S, const Epi& E, unsigned long long* stamps) {
    int tid_l = threadIdx.x; asm volatile("" : "+v"(tid_l));
    const int tid = tid_l, wid = __builtin_amdgcn_readfirstlane(tid >> 6), lane = tid & 63, wr = wid >> 2, wc = wid & 3, fr = lane & 15, fq = lane >> 4;
    const int K = g.K, nt = K / BK;
    int ts_lo = 0, ts_hi = 0, nts = 0; const unsigned long long rt_entry = STAMP ? (unsigned long long)wall_clock64() : 0ull;
#define PG8_STAMP() do { if (STAMP && wid == 0 && nts < 64) { const unsigned long long _c = (unsigned long long)clock64(); \
        ts_lo = (lane == nts) ? (int)(unsigned)_c : ts_lo; ts_hi = (lane == nts) ? (int)(unsigned)(_c >> 32) : ts_hi; ++nts; } } while (0)
    PG8_STAMP();
    unsigned voffA[2], voffB[2];
#pragma unroll
    for (int i = 0; i < 2; ++i) { int R, C; stage_rc(tid * 16 + i * 8192, R, C); const int Rb = Epi::PERM ? ((R & ~31) + perm32(R & 31)) : R;
        voffA[i] = (unsigned)(R * K + C) * 2u; voffB[i] = (unsigned)(Rb * K + C) * 2u; }
    const size_t kstep = (size_t)(BK * 2);
    const size_t hstep = (size_t)HALF * K * 2;
    const size_t tstep = 2 * hstep;
    const size_t ahs = HALFM ? 0 : hstep;
    const unsigned ldsw = (unsigned)wid * 1024u;
    const int aoff = lds_byte(wr * 64 + fr, fq * 8), boff = lds_byte(wc * 32 + fr, fq * 8);
#define PG8_SA(b, h) (((b) * 2 + (h)) * HTB)
#define PG8_SB(b, h) ((4 + (b) * 2 + (h)) * HTB)
#define PG8_STAGE(bufoff, gbase, voff) do { _Pragma("unroll") for (int _i = 0; _i < 2; ++_i) \
        __builtin_amdgcn_global_load_lds((const unsigned*)((const char*)(gbase) + (voff)[_i]), (PG8_LAS unsigned*)(lds + (bufoff) + ldsw + _i * 8192), 16, 0, 0); } while (0)
#define PG8_LDA(dst, b, h) do { _Pragma("unroll") for (int m = 0; m < 4; ++m) _Pragma("unroll") for (int k = 0; k < 2; ++k) dst[m][k] = *(const PG8_LAS bf16x8*)(lds + PG8_SA(b, h) + aoff + m * 2048 + k * 1024); } while (0)
#define PG8_LDB(dst, b, h) do { _Pragma("unroll") for (int n = 0; n < 2; ++n) _Pragma("unroll") for (int k = 0; k < 2; ++k) dst[n][k] = *(const PG8_LAS bf16x8*)(lds + PG8_SB(b, h) + boff + n * 2048 + k * 1024); } while (0)
#define PG8_MMA(ai, bj, At, Bt) do { __builtin_amdgcn_s_setprio(1); _Pragma("unroll") for (int m = 0; m < 4; ++m) _Pragma("unroll") for (int n = 0; n < 2; ++n) _Pragma("unroll") for (int k = 0; k < 2; ++k) \
        acc[ai][bj][m][n] = __builtin_amdgcn_mfma_f32_16x16x32_bf16(Bt[n][k], At[m][k], acc[ai][bj][m][n], 0, 0, 0); __builtin_amdgcn_s_setprio(0); } while (0)
#define PG8_WAIT_V(n) asm volatile("s_waitcnt vmcnt(" #n ")" ::: "memory")
#define PG8_WAIT_L(n) asm volatile("s_waitcnt lgkmcnt(" #n ")" ::: "memory")
#define PG8_BAR __builtin_amdgcn_s_barrier()
#define PG8_SCHED __builtin_amdgcn_sched_barrier(0)
    Unit cur, nxt; int ui = 0;
    if (!S.next(0, cur)) return;
    f32x4 acc[2][2][4][2];
#pragma unroll
    for (int a = 0; a < 2; ++a)
#pragma unroll
        for (int b = 0; b < 2; ++b)
#pragma unroll
            for (int m = 0; m < 4; ++m)
#pragma unroll
                for (int n = 0; n < 2; ++n) acc[a][b][m][n] = (f32x4){0.f, 0.f, 0.f, 0.f};
    bf16x8 At[4][2], B0[2][2], B1[2][2];
    const char* cA = (const char*)g.A + (size_t)cur.pm * (HALFM ? hstep : tstep); const char* cB = (const char*)g.Bt + (size_t)cur.pn * tstep;
    S.a_ready(cur);
    PG8_STAGE(PG8_SB(0, 0), cB, voffB); PG8_STAGE(PG8_SA(0, 0), cA, voffA); PG8_STAGE(PG8_SB(0, 1), cB + hstep, voffB); PG8_STAGE(PG8_SA(0, 1), cA + ahs, voffA);
    if (wr == 1) PG8_BAR;
    PG8_WAIT_V(4); PG8_BAR;
    PG8_STAGE(PG8_SB(1, 0), cB + kstep, voffB); PG8_STAGE(PG8_SA(1, 0), cA + kstep, voffA); PG8_STAGE(PG8_SB(1, 1), cB + hstep + kstep, voffB);
    PG8_WAIT_V(6); PG8_BAR;
    PG8_STAMP();
    for (;;) {
        const bool has_next = S.next(ui + 1, nxt);
        const char* nA = has_next ? (const char*)g.A + (size_t)nxt.pm * (HALFM ? hstep : tstep) : cA; const char* nB = has_next ? (const char*)g.Bt + (size_t)nxt.pn * tstep : cB;
        for (int t = 0; t < nt; t += 2) {
            const bool last = (t == nt - 2);
            const char* a1 = cA + (size_t)(t + 1) * kstep;
            const char* a2 = last ? nA : cA + (size_t)(t + 2) * kstep; const char* b2 = last ? nB : cB + (size_t)(t + 2) * kstep;
            const char* a3 = a2 + kstep; const char* b3 = b2 + kstep;
            if (last && has_next) S.a_ready(nxt);
            PG8_LDB(B0, 0, 0); PG8_SCHED; PG8_LDA(At, 0, 0); PG8_STAGE(PG8_SA(1, 1), a1 + ahs, voffA);
            PG8_WAIT_L(8); PG8_BAR; PG8_WAIT_L(0); PG8_MMA(0, 0, At, B0); PG8_BAR; PG8_SCHED;
            PG8_LDB(B1, 0, 1); PG8_STAGE(PG8_SB(0, 0), b2, voffB);
            PG8_BAR; PG8_WAIT_L(0); PG8_MMA(0, 1, At, B1); PG8_BAR;
            if constexpr (!HALFM) { PG8_LDA(At, 0, 1); } PG8_STAGE(PG8_SA(0, 0), a2, voffA);
            PG8_BAR; PG8_WAIT_L(0); if constexpr (!HALFM) { PG8_MMA(1, 0, At, B0); } PG8_BAR; PG8_SCHED;
            PG8_STAGE(PG8_SB(0, 1), b2 + hstep, voffB);
            PG8_WAIT_V(6); PG8_BAR; if constexpr (!HALFM) { PG8_MMA(1, 1, At, B1); } PG8_BAR;
            PG8_LDB(B0, 1, 0); PG8_SCHED; PG8_LDA(At, 1, 0); PG8_STAGE(PG8_SA(0, 1), a2 + ahs, voffA);
            PG8_WAIT_L(8); PG8_BAR; PG8_WAIT_L(0); PG8_MMA(0, 0, At, B0); PG8_BAR; PG8_SCHED;
            PG8_LDB(B1, 1, 1); PG8_STAGE(PG8_SB(1, 0), b3, voffB);
            PG8_BAR; PG8_WAIT_L(0); PG8_MMA(0, 1, At, B1); PG8_BAR;
            if constexpr (!HALFM) { PG8_LDA(At, 1, 1); } PG8_STAGE(PG8_SA(1, 0), a3, voffA);
            PG8_BAR; PG8_WAIT_L(0); if constexpr (!HALFM) { PG8_MMA(1, 0, At, B0); } PG8_BAR; PG8_SCHED;
            PG8_STAGE(PG8_SB(1, 1), b3 + hstep, voffB);
            PG8_WAIT_V(6); PG8_BAR; if constexpr (!HALFM) { PG8_MMA(1, 1, At, B1); } PG8_BAR;
        }
        PG8_STAMP();
        if constexpr (!Epi::AFTER_DRAIN) { E(acc, cur, wr, wc, fr, fq); S.done(cur); }
        PG8_STAMP();
        if (!has_next) break;
#pragma unroll
        for (int a = 0; a < 2; ++a)
#pragma unroll
            for (int b = 0; b < 2; ++b)
#pragma unroll
                for (int m = 0; m < 4; ++m)
#pragma unroll
                    for (int n = 0; n < 2; ++n) acc[a][b][m][n] = (f32x4){0.f, 0.f, 0.f, 0.f};
        cur = nxt; cA = nA; cB = nB; ++ui;
    }
    PG8_WAIT_V(0);
    if (wr == 0) PG8_BAR;
    PG8_BAR;
    if constexpr (Epi::AFTER_DRAIN) { E.fused(acc, cur, wr, wc, fr, fq, lds, wid, lane); S.done(cur); }
    PG8_STAMP();
    if (STAMP && wid == 0) { stamps[lane] = lane < nts ? (((unsigned long long)(unsigned)ts_hi << 32) | (unsigned)ts_lo) : 0ull;
        if (lane == 62) stamps[62] = rt_entry; if (lane == 63) stamps[63] = (unsigned long long)wall_clock64(); }
#undef PG8_STAMP
#undef PG8_SA
#undef PG8_SB
#undef PG8_STAGE
#undef PG8_LDA
#undef PG8_LDB
#undef PG8_MMA
#undef PG8_WAIT_V
#undef PG8_WAIT_L
#undef PG8_BAR
#undef PG8_SCHED
}
}
namespace pg8 {
template <class Epi, class Sched, bool ALIGN_EPI = false, bool SP2 = false, bool HALFM = false>
__device__ __forceinline__ void gemm_phase2(PG8_LAS unsigned char* lds, const Gemm g, const Sched& S, const Epi& E) {
    int tid_l = threadIdx.x; asm volatile("" : "+v"(tid_l));
    const int tid = tid_l, wid = __builtin_amdgcn_readfirstlane(tid >> 6), lane = tid & 63, wr = wid >> 2, wc = wid & 3, fr = lane & 15, fq = lane >> 4;
    const int K = g.K, nt = K / BK;
    unsigned voffA[2], voffB[2];
#pragma unroll
    for (int i = 0; i < 2; ++i) { int R, C; stage_rc(tid * 16 + i * 8192, R, C); const int Rb = Epi::PERM ? ((R & ~31) + perm32(R & 31)) : R;
        voffA[i] = (unsigned)(R * K + C) * 2u; voffB[i] = (unsigned)(Rb * K + C) * 2u; }
    const size_t kstep = (size_t)(BK * 2);
    const size_t hstep = (size_t)HALF * K * 2;
    const size_t tstep = 2 * hstep;
    const size_t ahs = HALFM ? 0 : hstep;
    const unsigned ldsw = (unsigned)wid * 1024u;
    const int aoff = lds_byte(wr * 64 + fr, fq * 8), boff = lds_byte(wc * 32 + fr, fq * 8);
#define PG8_SA(b, h) (((b) * 2 + (h)) * HTB)
#define PG8_SB(b, h) ((4 + (b) * 2 + (h)) * HTB)
#define PG8_STAGE(bufoff, gbase, voff) do { _Pragma("unroll") for (int _i = 0; _i < 2; ++_i) \
        __builtin_amdgcn_global_load_lds((const unsigned*)((const char*)(gbase) + (voff)[_i]), (PG8_LAS unsigned*)(lds + (bufoff) + ldsw + _i * 8192), 16, 0, 0); } while (0)
#define PG8_LDA(dst, b, h) do { _Pragma("unroll") for (int m = 0; m < 4; ++m) _Pragma("unroll") for (int k = 0; k < 2; ++k) dst[m][k] = *(const PG8_LAS bf16x8*)(lds + PG8_SA(b, h) + aoff + m * 2048 + k * 1024); } while (0)
#define PG8_LDB(dst, b, h) do { _Pragma("unroll") for (int n = 0; n < 2; ++n) _Pragma("unroll") for (int k = 0; k < 2; ++k) dst[n][k] = *(const PG8_LAS bf16x8*)(lds + PG8_SB(b, h) + boff + n * 2048 + k * 1024); } while (0)
#define PG8_MMA(ai, bj, At, Bt) do { __builtin_amdgcn_s_setprio(1); _Pragma("unroll") for (int m = 0; m < 4; ++m) _Pragma("unroll") for (int n = 0; n < 2; ++n) _Pragma("unroll") for (int k = 0; k < 2; ++k) \
        acc[ai][bj][m][n] = __builtin_amdgcn_mfma_f32_16x16x32_bf16(Bt[n][k], At[m][k], acc[ai][bj][m][n], 0, 0, 0); __builtin_amdgcn_s_setprio(0); } while (0)
#define PG8_WAIT_V(n) asm volatile("s_waitcnt vmcnt(" #n ")" ::: "memory")
#define PG8_WAIT_L(n) asm volatile("s_waitcnt lgkmcnt(" #n ")" ::: "memory")
#define PG8_BAR __builtin_amdgcn_s_barrier()
#define PG8_SCHED __builtin_amdgcn_sched_barrier(0)
    Unit cur, nxt; int ui = 0;
    if (!S.next(0, cur)) return;
    f32x4 acc[2][2][4][2];
#pragma unroll
    for (int a = 0; a < 2; ++a)
#pragma unroll
        for (int b = 0; b < 2; ++b)
#pragma unroll
            for (int m = 0; m < 4; ++m)
#pragma unroll
                for (int n = 0; n < 2; ++n) acc[a][b][m][n] = (f32x4){0.f, 0.f, 0.f, 0.f};
    bf16x8 At[4][2], B0[2][2], B1[2][2];
    const char* cA = (const char*)g.A + (size_t)cur.pm * (HALFM ? hstep : tstep); const char* cB = (const char*)g.Bt + (size_t)cur.pn * tstep;
    S.a_ready(cur);
    if constexpr (SP2) {
        PG8_STAGE(PG8_SB(0, 0), cB, voffB); PG8_STAGE(PG8_SB(0, 1), cB + hstep, voffB); PG8_STAGE(PG8_SA(0, 0), cA, voffA); PG8_STAGE(PG8_SA(0, 1), cA + ahs, voffA);
        if (wr == 1) PG8_BAR;
        PG8_WAIT_V(2); PG8_BAR;
        PG8_STAGE(PG8_SB(1, 0), cB + kstep, voffB); PG8_STAGE(PG8_SA(1, 0), cA + kstep, voffA); PG8_STAGE(PG8_SB(1, 1), cB + hstep + kstep, voffB);
        PG8_WAIT_V(6); PG8_BAR;
    } else {
        PG8_STAGE(PG8_SB(0, 0), cB, voffB); PG8_STAGE(PG8_SA(0, 0), cA, voffA); PG8_STAGE(PG8_SB(0, 1), cB + hstep, voffB); PG8_STAGE(PG8_SA(0, 1), cA + ahs, voffA);
        if (wr == 1) PG8_BAR;
        PG8_WAIT_V(4); PG8_BAR;
        PG8_STAGE(PG8_SB(1, 0), cB + kstep, voffB); PG8_STAGE(PG8_SA(1, 0), cA + kstep, voffA); PG8_STAGE(PG8_SB(1, 1), cB + hstep + kstep, voffB);
        PG8_WAIT_V(6); PG8_BAR;
    }
    for (;;) {
        const bool has_next = S.next(ui + 1, nxt);
        const char* nA = has_next ? (const char*)g.A + (size_t)nxt.pm * (HALFM ? hstep : tstep) : cA; const char* nB = has_next ? (const char*)g.Bt + (size_t)nxt.pn * tstep : cB;
        for (int t = 0; t < nt; t += 2) {
            const bool last = (t == nt - 2);
            const char* a1 = cA + (size_t)(t + 1) * kstep;
            const char* a2 = last ? nA : cA + (size_t)(t + 2) * kstep; const char* b2 = last ? nB : cB + (size_t)(t + 2) * kstep;
            const char* a3 = a2 + kstep; const char* b3 = b2 + kstep;
            if (last && has_next) S.a_ready(nxt);
            if constexpr (SP2) {
            PG8_LDB(B0, 0, 0); PG8_LDB(B1, 0, 1); PG8_SCHED; PG8_LDA(At, 0, 0); PG8_STAGE(PG8_SA(1, 1), a1 + ahs, voffA);
            PG8_WAIT_V(8); PG8_WAIT_L(0); PG8_BAR; PG8_MMA(0, 0, At, B0); if constexpr (!HALFM) { PG8_MMA(0, 1, At, B1); } PG8_BAR; PG8_SCHED;
            if constexpr (!HALFM) { PG8_LDA(At, 0, 1); } PG8_STAGE(PG8_SB(0, 0), b2, voffB); PG8_STAGE(PG8_SB(0, 1), b2 + hstep, voffB); PG8_STAGE(PG8_SA(0, 0), a2, voffA);
            PG8_WAIT_V(8); PG8_WAIT_L(0); PG8_BAR; if constexpr (!HALFM) { PG8_MMA(1, 0, At, B0); PG8_MMA(1, 1, At, B1); } else { PG8_MMA(0, 1, At, B1); } PG8_BAR; PG8_SCHED;
            PG8_LDB(B0, 1, 0); PG8_LDB(B1, 1, 1); PG8_SCHED; PG8_LDA(At, 1, 0); PG8_STAGE(PG8_SA(0, 1), a2 + ahs, voffA);
            PG8_WAIT_V(8); PG8_WAIT_L(0); PG8_BAR; PG8_MMA(0, 0, At, B0); if constexpr (!HALFM) { PG8_MMA(0, 1, At, B1); } PG8_BAR; PG8_SCHED;
            if constexpr (!HALFM) { PG8_LDA(At, 1, 1); } PG8_STAGE(PG8_SB(1, 0), b3, voffB); PG8_STAGE(PG8_SB(1, 1), b3 + hstep, voffB); PG8_STAGE(PG8_SA(1, 0), a3, voffA);
            PG8_WAIT_V(8); PG8_WAIT_L(0); PG8_BAR; if constexpr (!HALFM) { PG8_MMA(1, 0, At, B0); PG8_MMA(1, 1, At, B1); } else { PG8_MMA(0, 1, At, B1); } PG8_BAR; PG8_SCHED;
            } else {
            PG8_LDB(B0, 0, 0); PG8_SCHED; PG8_LDA(At, 0, 0); PG8_STAGE(PG8_SA(1, 1), a1 + ahs, voffA);
            PG8_WAIT_L(8); PG8_BAR; PG8_WAIT_L(0); PG8_MMA(0, 0, At, B0); PG8_BAR; PG8_SCHED;
            PG8_LDB(B1, 0, 1); PG8_STAGE(PG8_SB(0, 0), b2, voffB);
            PG8_BAR; PG8_WAIT_L(0); PG8_MMA(0, 1, At, B1); PG8_BAR;
            if constexpr (!HALFM) { PG8_LDA(At, 0, 1); } PG8_STAGE(PG8_SA(0, 0), a2, voffA);
            PG8_BAR; PG8_WAIT_L(0); if constexpr (!HALFM) { PG8_MMA(1, 0, At, B0); } PG8_BAR; PG8_SCHED;
            PG8_STAGE(PG8_SB(0, 1), b2 + hstep, voffB);
            PG8_WAIT_V(6); PG8_BAR; if constexpr (!HALFM) { PG8_MMA(1, 1, At, B1); } PG8_BAR;
            PG8_LDB(B0, 1, 0); PG8_SCHED; PG8_LDA(At, 1, 0); PG8_STAGE(PG8_SA(0, 1), a2 + ahs, voffA);
            PG8_WAIT_L(8); PG8_BAR; PG8_WAIT_L(0); PG8_MMA(0, 0, At, B0); PG8_BAR; PG8_SCHED;
            PG8_LDB(B1, 1, 1); PG8_STAGE(PG8_SB(1, 0), b3, voffB);
            PG8_BAR; PG8_WAIT_L(0); PG8_MMA(0, 1, At, B1); PG8_BAR;
            if constexpr (!HALFM) { PG8_LDA(At, 1, 1); } PG8_STAGE(PG8_SA(1, 0), a3, voffA);
            PG8_BAR; PG8_WAIT_L(0); if constexpr (!HALFM) { PG8_MMA(1, 0, At, B0); } PG8_BAR; PG8_SCHED;
            PG8_STAGE(PG8_SB(1, 1), b3 + hstep, voffB);
            PG8_WAIT_V(6); PG8_BAR; if constexpr (!HALFM) { PG8_MMA(1, 1, At, B1); } PG8_BAR;
            }
        }
        if constexpr (ALIGN_EPI) { if (wr == 0) PG8_BAR; }
        if constexpr (!Epi::AFTER_DRAIN) { E(acc, cur, wr, wc, fr, fq); S.done(cur); }
        if (!has_next) break;
#pragma unroll
        for (int a = 0; a < 2; ++a)
#pragma unroll
            for (int b = 0; b < 2; ++b)
#pragma unroll
                for (int m = 0; m < 4; ++m)
#pragma unroll
                    for (int n = 0; n < 2; ++n) acc[a][b][m][n] = (f32x4){0.f, 0.f, 0.f, 0.f};
        cur = nxt; cA = nA; cB = nB; ++ui;
        if constexpr (ALIGN_EPI) { if (wr == 1) PG8_BAR; }
    }
    PG8_WAIT_V(0);
    if constexpr (!ALIGN_EPI) { if (wr == 0) PG8_BAR; }
    PG8_BAR;
    if constexpr (Epi::AFTER_DRAIN) { E.fused(acc, cur, wr, wc, fr, fq, lds, wid, lane); S.done(cur); }
#undef PG8_SA
#undef PG8_SB
#undef PG8_STAGE
#undef PG8_LDA
#undef PG8_LDB
#undef PG8_MMA
#undef PG8_WAIT_V
#undef PG8_WAIT_L
#undef PG8_BAR
#undef PG8_SCHED
}

}

#ifndef REPMASK
#define REPMASK 0u
#endif
constexpr int NTHR = 512;
constexpr int TOK = 8192;
constexpr float EPSF = 1e-6f;
constexpr size_t MiB = 1048576;
constexpr size_t WS_MOD = 0, WS_ATOT = 131072, WS_XBAR = 262144, WS_QCNT = 393216;
constexpr size_t WS_G = 1 * MiB, WS_TAB = 33 * MiB, WS_DT = 41 * MiB, WS_OATT = 43 * MiB;
constexpr size_t WS_HB = 59 * MiB, WS_BT = 59 * MiB, WS_YG = 59 * MiB;
constexpr size_t WS_WIN = 75 * MiB, WS_BN = 75 * MiB;
constexpr size_t WS_QK = 98 * MiB, WS_Z = 98 * MiB, WS_ACT = 98 * MiB;
constexpr size_t WS_V = 130 * MiB, WS_XBC = 130 * MiB, WS_YD = 130 * MiB, WS_MA = 130 * MiB;
constexpr size_t WS_QN = 146 * MiB, WS_KNI = 162 * MiB, WS_KNII = 170 * MiB, WS_VTI = 182 * MiB, WS_VTII = 190 * MiB;
constexpr size_t WS_YF = 162 * MiB, WS_MERGED = 162 * MiB, WS_H2 = 178 * MiB;
constexpr size_t WS_CN = 194 * MiB, WS_WD = 194 * MiB, WS_WA = 253 * MiB, WS_WB = 242 * MiB, WS_WOUT = 246 * MiB;
constexpr size_t WS_YB = 210 * MiB, WS_WGU = 242 * MiB;
constexpr size_t TABSZ = 64 * 8192;
constexpr int LDS_BYTES = 153600;

struct Params { const float* in[32]; float* out; unsigned char* ws; };

using pg8::Unit;
struct EpiIn1 {
    static constexpr bool PERM = true, AFTER_DRAIN = false;
    bf16_t* qk; bf16_t* v; bf16_t* g; float* dt; float* ncv;
    DI void operator()(const f32x4 (&acc)[2][2][4][2], const Unit& u, int wr, int wc, int fr, int fq) const {
        const int row0 = u.pm * 256 + wr * 64 + fr, cl = wc * 32 + 8 * fq, pn = u.pn;
        if (pn == 20) {
            if (wc < 2) {
#pragma unroll
                for (int ai = 0; ai < 2; ++ai)
#pragma unroll
                    for (int m = 0; m < 4; ++m) { float* d = dt + (size_t)(row0 + ai * 128 + m * 16) * 64 + cl; *(f32x4*)d = acc[ai][0][m][0]; *(f32x4*)(d + 4) = acc[ai][0][m][1]; }
            }
            return;
        }
        bf16_t* base; int ld;
        if (pn < 8) { base = qk + pn * 256; ld = 2048; } else if (pn < 12) { base = v + (pn - 8) * 256; ld = 1024; } else { base = g + (pn - 12) * 256; ld = 2048; }
        const bool isg = pn >= 12, isv = (pn >= 8 && pn < 12 && u.pm < 16);
#pragma unroll
        for (int ai = 0; ai < 2; ++ai)
#pragma unroll
            for (int m = 0; m < 4; ++m) {
                const int row = row0 + ai * 128 + m * 16;
#pragma unroll
                for (int bj = 0; bj < 2; ++bj) {
                    f32x4 v0 = acc[ai][bj][m][0], v1 = acc[ai][bj][m][1];
                    if (isv) { float* o = ncv + (size_t)row * 1024 + (pn - 8) * 256 + bj * 128 + cl; *(f32x4*)o = v0; *(f32x4*)(o + 4) = v1; }
                    if (isg) {
#pragma unroll
                        for (int j = 0; j < 4; ++j) { v0[j] = sigm(v0[j]); v1[j] = sigm(v1[j]); } }
                    u32x4 w; w[0] = pk2(v0[0], v0[1]); w[1] = pk2(v0[2], v0[3]); w[2] = pk2(v1[0], v1[1]); w[3] = pk2(v1[2], v1[3]);
                    *(u32x4*)(base + (size_t)row * ld + bj * 128 + cl) = w;
                }
            }
    }
};
struct EpiIn2 {
    static constexpr bool PERM = true, AFTER_DRAIN = false;
    bf16_t* z; bf16_t* xbc;
    DI void operator()(const f32x4 (&acc)[2][2][4][2], const Unit& u, int wr, int wc, int fr, int fq) const {
        const int row0 = u.pm * 256 + wr * 64 + fr, cl = wc * 32 + 8 * fq, pn = u.pn;
        bf16_t* base; int ld;
        if (pn < 8) { base = z + pn * 256; ld = 2048; } else { base = xbc + (pn - 8) * 256; ld = 4096; }
#pragma unroll
        for (int ai = 0; ai < 2; ++ai)
#pragma unroll
            for (int m = 0; m < 4; ++m) {
                const int row = row0 + ai * 128 + m * 16;
#pragma unroll
                for (int bj = 0; bj < 2; ++bj) {
                    const f32x4 v0 = acc[ai][bj][m][0], v1 = acc[ai][bj][m][1];
                    u32x4 w; w[0] = pk2(v0[0], v0[1]); w[1] = pk2(v0[2], v0[3]); w[2] = pk2(v1[0], v1[1]); w[3] = pk2(v1[2], v1[3]);
                    *(u32x4*)(base + (size_t)row * ld + bj * 128 + cl) = w;
                }
            }
    }
};
template <int SECOND, int HM> struct EpiBranch {
    static constexpr bool PERM = true, AFTER_DRAIN = false;
    const bf16_t* g; bf16_t* m2; u32x4* keep;
    DI void operator()(const f32x4 (&acc)[2][2][4][2], const Unit& u, int wr, int wc, int fr, int fq) const {
        const int row0 = u.pm * (HM ? 128 : 256) + wr * 64 + fr, col0 = u.pn * 256 + wc * 32 + 8 * fq;
        constexpr int NQ = HM ? 4 : 8;
#pragma unroll
        for (int bj = 0; bj < 2; ++bj) {
            const int c = col0 + bj * 128;
            u32x4 gg[NQ];
#pragma unroll
            for (int q = 0; q < NQ; ++q) { const int row = row0 + (q >> 2) * 128 + (q & 3) * 16; gg[q] = *(const u32x4*)(g + (size_t)row * 2048 + SECOND * 1024 + c); }
#pragma unroll
            for (int q = 0; q < NQ; ++q) { const int row = row0 + (q >> 2) * 128 + (q & 3) * 16;
                const f32x4 a0 = acc[q >> 2][bj][q & 3][0], a1 = acc[q >> 2][bj][q & 3][1];
                float r[8];
                r[0] = bflo(gg[q][0]) * a0[0]; r[1] = bfhi(gg[q][0]) * a0[1]; r[2] = bflo(gg[q][1]) * a0[2]; r[3] = bfhi(gg[q][1]) * a0[3];
                r[4] = bflo(gg[q][2]) * a1[0]; r[5] = bfhi(gg[q][2]) * a1[1]; r[6] = bflo(gg[q][3]) * a1[2]; r[7] = bfhi(gg[q][3]) * a1[3];
                if (SECOND == 0) { const u32x4 pv = keep[bj * NQ + q];
#pragma unroll
                    for (int j = 0; j < 4; ++j) { r[2 * j] += bflo(pv[j]); r[2 * j + 1] += bfhi(pv[j]); } }
                u32x4 w; w[0] = pk2(r[0], r[1]); w[1] = pk2(r[2], r[3]); w[2] = pk2(r[4], r[5]); w[3] = pk2(r[6], r[7]);
                if (SECOND == 1) keep[bj * NQ + q] = w; else *(u32x4*)(m2 + (size_t)row * 1024 + c) = w; }
        }
    }
};
template <int FINAL, int HM> struct EpiRes {
    static constexpr bool PERM = false, AFTER_DRAIN = false;
    const float* xa; const float* xb; const float* mod; float* out;
    DI void operator()(const f32x4 (&acc)[2][2][4][2], const Unit& u, int wr, int wc, int fr, int fq) const {
        const int row0 = u.pm * (HM ? 128 : 256) + wr * 64 + fr, col0 = u.pn * 256 + wc * 32 + 4 * fq;
        const int pm256 = HM ? (u.pm >> 1) : u.pm;
        const int mi = pm256 < 16 ? 0 : 1 + ((pm256 - 16) >> 2);
        const float* gate = mod + mi * 6144 + (FINAL ? 5120 : 2048);
        constexpr int NQ = HM ? 4 : 8;
#pragma unroll
        for (int bj = 0; bj < 2; ++bj)
#pragma unroll
            for (int n = 0; n < 2; ++n) {
                const int c = col0 + bj * 128 + n * 16;
                const f32x4 gt = *(const f32x4*)(gate + c);
                f32x4 xv[NQ];
#pragma unroll
                for (int q = 0; q < NQ; ++q) { const int row = row0 + (q >> 2) * 128 + (q & 3) * 16;
                    const float* xp = FINAL ? (out + (size_t)row * 1024 + c) : ((row < 4096 ? xa + (size_t)row * 1024 : xb + (size_t)(row - 4096) * 1024) + c);
                    xv[q] = *(const f32x4*)xp; }
#pragma unroll
                for (int q = 0; q < NQ; ++q) { const int row = row0 + (q >> 2) * 128 + (q & 3) * 16;
                    *(f32x4*)(out + (size_t)row * 1024 + c) = xv[q] + gt * acc[q >> 2][bj][q & 3][n]; }
            }
    }
};
struct EpiUp {
    static constexpr bool PERM = true, AFTER_DRAIN = false;
    bf16_t* act;
    DI void operator()(const f32x4 (&acc)[2][2][4][2], const Unit& u, int wr, int wc, int fr, int fq) const {
        const int row0 = u.pm * 256 + wr * 64 + fr, col = u.pn * 128 + wc * 32 + 8 * fq;
#pragma unroll
        for (int ai = 0; ai < 2; ++ai)
#pragma unroll
            for (int m = 0; m < 4; ++m) {
                const int row = row0 + ai * 128 + m * 16;
                float r[8];
#pragma unroll
                for (int n = 0; n < 2; ++n)
#pragma unroll
                    for (int j = 0; j < 4; ++j) r[n * 4 + j] = silu(acc[ai][0][m][n][j]) * acc[ai][1][m][n][j];
                u32x4 w; w[0] = pk2(r[0], r[1]); w[1] = pk2(r[2], r[3]); w[2] = pk2(r[4], r[5]); w[3] = pk2(r[6], r[7]);
                *(u32x4*)(act + (size_t)row * 2816 + col) = w;
            }
    }
};

struct WT { const float* src; bf16_t* dst; int N, K; };
struct Params;
template <int WHICH> DI WT wt_decode(const float* const* in, unsigned char* ws, int t);
template <int WHICH> DI void wconv_loop(const float* const* in, unsigned char* ws, int ntiles, int t0, int tstride, unsigned char* lds, int tid) {
    asm volatile("" : "+v"(tid));
    bf16_t* T = (bf16_t*)lds;
    int t = t0; if (t >= ntiles) return;
    WT cur = wt_decode<WHICH>(in, ws, t);
    const int kr0 = tid >> 4, c4 = tid & 15;
    f32x4 r0 = {0.f, 0.f, 0.f, 0.f}, r1 = r0;
    if (cur.src) { r0 = *(const f32x4*)(cur.src + (size_t)kr0 * cur.N + 4 * c4); r1 = *(const f32x4*)(cur.src + (size_t)(kr0 + 32) * cur.N + 4 * c4); }
    for (;;) {
        const int tn = t + tstride; const bool has = tn < ntiles;
        WT nx = cur; f32x4 n0 = {0.f, 0.f, 0.f, 0.f}, n1 = n0;
        if (has) { nx = wt_decode<WHICH>(in, ws, tn);
            if (nx.src) { n0 = *(const f32x4*)(nx.src + (size_t)kr0 * nx.N + 4 * c4); n1 = *(const f32x4*)(nx.src + (size_t)(kr0 + 32) * nx.N + 4 * c4); } }
        { u32x2 w; w[0] = pk2(r0[0], r0[1]); w[1] = pk2(r0[2], r0[3]); *(u32x2*)(T + kr0 * 68 + 4 * c4) = w;
          u32x2 x; x[0] = pk2(r1[0], r1[1]); x[1] = pk2(r1[2], r1[3]); *(u32x2*)(T + (kr0 + 32) * 68 + 4 * c4) = x; }
        __syncthreads();
        { const int n = tid & 63, kq = tid >> 6; u32x4 w;
#pragma unroll
          for (int j = 0; j < 4; ++j) { const unsigned lo = T[(kq * 8 + 2 * j) * 68 + n], hi = T[(kq * 8 + 2 * j + 1) * 68 + n]; w[j] = lo | (hi << 16); }
          *(u32x4*)(cur.dst + (size_t)n * cur.K + kq * 8) = w; }
        __syncthreads();
        if (!has) break;
        cur = nx; r0 = n0; r1 = n1; t = tn;
    }
}
template <> DI WT wt_decode<0>(const float* const* in, unsigned char* ws, int t) {
    const int nb = t >> 4, kb = t & 15, nd = nb * 64; int ns;
    if (nd < 3072) ns = nd; else if (nd < 5120) ns = 9280 + (nd - 3072); else if (nd < 5184) ns = 9216 + (nd - 5120); else if (nd < 5376) ns = -1; else ns = 3072 + (nd - 5376);
    WT w; w.N = 11328; w.K = 1024; w.src = ns < 0 ? nullptr : in[12] + (size_t)(kb * 64) * 11328 + ns; w.dst = (bf16_t*)(ws + 75 * 1048576) + (size_t)nd * 1024 + kb * 64; return w;
}
template <> DI WT wt_decode<1>(const float* const* in, unsigned char* ws, int t) {
    WT w;
    if (t < 256) { const int nb = t >> 4, kb = t & 15; w.N = 1024; w.K = 1024; w.src = in[26] + (size_t)(kb * 64) * 1024 + nb * 64; w.dst = (bf16_t*)(ws + 253 * 1048576) + (size_t)(nb * 64) * 1024 + kb * 64; }
    else if (t < 768) { const int q = t - 256, nb = q >> 5, kb = q & 31; w.N = 1024; w.K = 2048; w.src = in[27] + (size_t)(kb * 64) * 1024 + nb * 64; w.dst = (bf16_t*)(ws + 242 * 1048576) + (size_t)(nb * 64) * 2048 + kb * 64; }
    else { const int q = t - 768, nb = q >> 4, kb = q & 15; w.N = 1024; w.K = 1024; w.src = in[28] + (size_t)(kb * 64) * 1024 + nb * 64; w.dst = (bf16_t*)(ws + 246 * 1048576) + (size_t)(nb * 64) * 1024 + kb * 64; }
    return w;
}
template <> DI WT wt_decode<2>(const float* const* in, unsigned char* ws, int t) {
    WT w;
    if (t < 1408) { const int nb = t >> 4, kb = t & 15, pn = nb >> 2, qq = nb & 3; w.N = 2816; w.K = 1024;
        w.src = (qq < 2 ? in[29] : in[30]) + (size_t)(kb * 64) * 2816 + pn * 128 + (qq & 1) * 64; w.dst = (bf16_t*)(ws + 242 * 1048576) + (size_t)(nb * 64) * 1024 + kb * 64; }
    else { const int q = t - 1408, nb = q / 44, kb = q % 44; w.N = 1024; w.K = 2816; w.src = in[31] + (size_t)(kb * 64) * 1024 + nb * 64; w.dst = (bf16_t*)(ws + 194 * 1048576) + (size_t)(nb * 64) * 2816 + kb * 64; }
    return w;
}

DI void norm_rows(const float* __restrict__ xa, const float* __restrict__ xb, const float* __restrict__ g, const float* __restrict__ mod, int shift_off, int scale_off, bf16_t* __restrict__ dst, int gw, int nw, int lane) {
    asm volatile("" : "+v"(lane));
#pragma unroll 2
    for (int row = gw; row < TOK; row += nw) {
        const float* xr = row < 4096 ? xa + (size_t)row * 1024 : xb + (size_t)(row - 4096) * 1024;
        const float* mm = mod + (row < 4096 ? 0 : 1 + ((row - 4096) >> 10)) * 6144;
        f32x4 v[4], ggv[4], scv[4], shv[4]; float ss = 0.f;
#pragma unroll
        for (int i = 0; i < 4; ++i) { const int c = lane * 16 + i * 4; v[i] = *(const f32x4*)(xr + c); ggv[i] = *(const f32x4*)(g + c); scv[i] = *(const f32x4*)(mm + scale_off + c); shv[i] = *(const f32x4*)(mm + shift_off + c); }
#pragma unroll
        for (int i = 0; i < 4; ++i) ss += v[i][0] * v[i][0] + v[i][1] * v[i][1] + v[i][2] * v[i][2] + v[i][3] * v[i][3];
        ss = wsum(ss);
        const float rstd = rsqrtf(ss * (1.0f / 1024.0f) + EPSF);
        u32x4 w[2];
#pragma unroll
        for (int i = 0; i < 4; ++i) {
            const f32x4 gg = ggv[i], sc = scv[i], sh = shv[i];
            f32x4 h;
#pragma unroll
            for (int j = 0; j < 4; ++j) h[j] = v[i][j] * rstd * gg[j] * (1.0f + sc[j]) + sh[j];
            w[i >> 1][(i & 1) * 2] = pk2(h[0], h[1]); w[i >> 1][(i & 1) * 2 + 1] = pk2(h[2], h[3]); }
        *(u32x4*)(dst + (size_t)row * 1024 + lane * 16) = w[0]; *(u32x4*)(dst + (size_t)row * 1024 + lane * 16 + 8) = w[1];
    }
}

constexpr int AT_KST = 144, AT_VST = 144, AT_K1 = 64 * AT_KST, AT_V = 2 * 64 * AT_KST, AT_BUF = AT_V + 128 * AT_VST;
DI void attn_unit(const bf16_t* __restrict__ q0p, const bf16_t* __restrict__ q1p, const bf16_t* __restrict__ k0p, const bf16_t* __restrict__ k1p,
                  const bf16_t* __restrict__ vtp, int ldv, int nk, bf16_t* __restrict__ outp, float lam, const float* __restrict__ subg, unsigned char* lds, int tid) {
    asm volatile("" : "+v"(tid));
    const int lane = tid & 63, wv = tid >> 6, r = lane & 31, hh = lane >> 5, comp = wv >> 2, qg = wv & 3;
    const bf16_t* qp = (comp ? q1p : q0p) + (size_t)(qg * 32 + r) * 64 + hh * 8;
    bf16x8 qf[4];
#pragma unroll
    for (int ks = 0; ks < 4; ++ks) qf[ks] = *(const bf16x8*)(qp + ks * 16);
    f32x16 o[4];
#pragma unroll
    for (int i = 0; i < 4; ++i) o[i] = zero16();
    float l = 0.f;
    const int kc0 = tid, kc1 = tid + 512;
    const bf16_t* kg0 = (kc0 >> 9 ? k1p : k0p) + (size_t)((kc0 >> 3) & 63) * 64 + (kc0 & 7) * 8;
    const bf16_t* kg1 = (kc1 >> 9 ? k1p : k0p) + (size_t)((kc1 >> 3) & 63) * 64 + (kc1 & 7) * 8;
    const int kl0 = (kc0 >> 9) * AT_K1 + ((kc0 >> 3) & 63) * AT_KST + (kc0 & 7) * 16, kl1 = (kc1 >> 9) * AT_K1 + ((kc1 >> 3) & 63) * AT_KST + (kc1 & 7) * 16;
    const bf16_t* vg0 = vtp + (size_t)(kc0 >> 3) * ldv + (kc0 & 7) * 8; const bf16_t* vg1 = vtp + (size_t)(kc1 >> 3) * ldv + (kc1 & 7) * 8;
    const int vl0 = AT_V + (kc0 >> 3) * AT_VST + ((kc0 & 7) >> 1) * 32 + (kc0 & 1) * 8, vl1 = AT_V + (kc1 >> 3) * AT_VST + ((kc1 & 7) >> 1) * 32 + (kc1 & 1) * 8;
    u32x4 sa[4], sb[4];
#define AT_LOAD(S, tt) do { const size_t ko_ = (size_t)(tt) * 64 * 64; const int vo_ = (tt) * 64; \
        const bf16_t* p0_ = kg0 + ko_; const bf16_t* p1_ = kg1 + ko_; const bf16_t* p2_ = vg0 + vo_; const bf16_t* p3_ = vg1 + vo_; \
        asm volatile("global_load_dwordx4 %0, %1, off" : "=v"(S[0]) : "v"(p0_) : "memory"); asm volatile("global_load_dwordx4 %0, %1, off" : "=v"(S[1]) : "v"(p1_) : "memory"); \
        asm volatile("global_load_dwordx4 %0, %1, off" : "=v"(S[2]) : "v"(p2_) : "memory"); asm volatile("global_load_dwordx4 %0, %1, off" : "=v"(S[3]) : "v"(p3_) : "memory"); } while (0)
#define AT_WAIT4(S) asm volatile("s_waitcnt vmcnt(4)" : "+v"(S[0]), "+v"(S[1]), "+v"(S[2]), "+v"(S[3]) : : "memory")
#define AT_WAIT0(S) asm volatile("s_waitcnt vmcnt(0)" : "+v"(S[0]), "+v"(S[1]), "+v"(S[2]), "+v"(S[3]) : : "memory")
#define AT_STORE(S, W) do { *(u32x4*)((W) + kl0) = S[0]; *(u32x4*)((W) + kl1) = S[1]; \
        *(u32x2*)((W) + vl0) = (u32x2){S[2][0], S[2][1]}; *(u32x2*)((W) + vl0 + 16) = (u32x2){S[2][2], S[2][3]}; \
        *(u32x2*)((W) + vl1) = (u32x2){S[3][0], S[3][1]}; *(u32x2*)((W) + vl1 + 16) = (u32x2){S[3][2], S[3][3]}; } while (0)
#define AT_COMPUTE(B) do { _Pragma("unroll") for (int kh = 0; kh < 2; ++kh) { \
            f32x16 s_ = zero16(); \
            _Pragma("unroll") for (int ks = 0; ks < 4; ++ks) s_ = MFMA32(*(const bf16x8*)((B) + kro + kh * 32 * AT_KST + ks * 32), qf[ks], s_); \
            _Pragma("unroll") for (int i = 0; i < 16; ++i) { s_[i] = __builtin_amdgcn_exp2f(s_[i]); l += s_[i]; } \
            const bf16x8 p0 = pack8<0>(s_), p1 = pack8<1>(s_); \
            _Pragma("unroll") for (int vt = 0; vt < 4; ++vt) { const unsigned char* vv = (B) + vro + vt * 32 * AT_VST + kh * 64; \
                const bf16x8 v0 = *(const bf16x8*)(vv), v1 = *(const bf16x8*)(vv + 32); \
                o[vt] = MFMA32(v0, p0, o[vt]); o[vt] = MFMA32(v1, p1, o[vt]); } } } while (0)
    const int nt = nk >> 6;
    const int kro = comp * AT_K1 + r * AT_KST + hh * 16, vro = AT_V + r * AT_VST + hh * 16;
    asm volatile("" : : "v"(qf[0]), "v"(qf[1]), "v"(qf[2]), "v"(qf[3]));
    AT_LOAD(sa, 0); AT_WAIT0(sa); AT_STORE(sa, lds);
    AT_LOAD(sa, 1);
    __syncthreads();
#pragma unroll 1
    for (int t = 0; t + 2 < nt; t += 2) {
        AT_LOAD(sb, t + 2);
        AT_COMPUTE(lds);
        AT_WAIT4(sa); AT_STORE(sa, lds + AT_BUF);
        __syncthreads();
        AT_LOAD(sa, t + 3);
        AT_COMPUTE(lds + AT_BUF);
        AT_WAIT4(sb); AT_STORE(sb, lds);
        __syncthreads();
    }
    AT_COMPUTE(lds);
    AT_WAIT0(sa); AT_STORE(sa, lds + AT_BUF);
    __syncthreads();
    AT_COMPUTE(lds + AT_BUF);
    __syncthreads();
#undef AT_LOAD
#undef AT_STORE
#undef AT_COMPUTE
#undef AT_WAIT4
#undef AT_WAIT0
    l += __shfl_xor(l, 32);
    float* X = (float*)lds;
    if (comp) { const float i1 = lam / l;
#pragma unroll
        for (int vt = 0; vt < 4; ++vt)
#pragma unroll
            for (int i = 0; i < 16; ++i) X[((qg * 4 + vt) * 16 + i) * 64 + lane] = o[vt][i] * i1; }
    __syncthreads();
    if (!comp) { const float i0 = 1.0f / l; float ss = 0.f;
#pragma unroll
        for (int vt = 0; vt < 4; ++vt)
#pragma unroll
            for (int i = 0; i < 16; ++i) { const float tv = o[vt][i] * i0 - X[((qg * 4 + vt) * 16 + i) * 64 + lane]; o[vt][i] = tv; ss += tv * tv; }
        ss += __shfl_xor(ss, 32);
        const float rs = rsqrtf(ss * (1.0f / 128.0f) + EPSF) * 0.8f;
        f32x4 sgv[16];
#pragma unroll
        for (int q = 0; q < 16; ++q) sgv[q] = *(const f32x4*)(subg + (q >> 2) * 32 + 8 * (q & 3) + 4 * hh);
#pragma unroll
        for (int vt = 0; vt < 4; ++vt)
#pragma unroll
            for (int g4 = 0; g4 < 4; ++g4) { const int vd0 = vt * 32 + 8 * g4 + 4 * hh; const f32x4 sg = sgv[vt * 4 + g4];
                u32x2 w; w[0] = pk2(o[vt][4 * g4] * rs * sg[0], o[vt][4 * g4 + 1] * rs * sg[1]); w[1] = pk2(o[vt][4 * g4 + 2] * rs * sg[2], o[vt][4 * g4 + 3] * rs * sg[3]);
                *(u32x2*)(outp + (size_t)(qg * 32 + r) * 1024 + vd0) = w; } }
    __syncthreads();
}

DI void store_yT1(const f32x16& y, float sc, bf16_t* __restrict__ yrow, int hh) {
#pragma unroll
    for (int g4 = 0; g4 < 4; ++g4) { u32x2 w; w[0] = pk2(y[4 * g4] * sc, y[4 * g4 + 1] * sc); w[1] = pk2(y[4 * g4 + 2] * sc, y[4 * g4 + 3] * sc); *(u32x2*)(yrow + 8 * g4 + 4 * hh) = w; }
}

DI void scan_item(int seq, int head, int dir, int pt, const bf16_t* __restrict__ XT, const bf16_t* __restrict__ BT, const bf16_t* __restrict__ CN,
                  const float* __restrict__ TE, const float* __restrict__ TW, const float* __restrict__ ATOT, const float* __restrict__ st_in, float* __restrict__ st_out,
                  bf16_t* __restrict__ Y, int lane) {
    const int r = lane & 31, hh = lane >> 5, g = head >> 2, col = dir * 32 + head;
    const int T0 = seq < 16 ? seq * 256 : 4096 + (seq - 16) * 1024, nc = seq < 16 ? 2 : 8;
    f32x16 H[4];
    if (seq < 16) {
#pragma unroll
        for (int nt = 0; nt < 4; ++nt) H[nt] = zero16();
    } else {
        const float* sp = st_in + ((size_t)((seq - 16) * 32 + head) * 64) * 128;
#pragma unroll
        for (int nt = 0; nt < 4; ++nt)
#pragma unroll
            for (int g4 = 0; g4 < 4; ++g4) { const f32x4 v = *(const f32x4*)(sp + (size_t)(pt * 32 + r) * 128 + nt * 32 + 8 * g4 + 4 * hh);
                H[nt][4 * g4] = v[0]; H[nt][4 * g4 + 1] = v[1]; H[nt][4 * g4 + 2] = v[2]; H[nt][4 * g4 + 3] = v[3]; }
    }
    const bf16_t* xrow = XT + (size_t)(head * 64 + pt * 32 + r) * 8192;
#pragma unroll 1
    for (int cc = 0; cc < nc; ++cc) {
        const int c = dir ? nc - 1 - cc : cc, t0 = T0 + c * 128;
        {
            bf16x8 hp[4][2];
#pragma unroll
            for (int nt = 0; nt < 4; ++nt) { hp[nt][0] = pack8<0>(H[nt]); hp[nt][1] = pack8<1>(H[nt]); }
#pragma unroll 1
            for (int lh = 0; lh < 2; ++lh) {
                s16x4 cl[2][4][4]; float ev[2];
#pragma unroll
                for (int l2 = 0; l2 < 2; ++l2) { const int lt = lh * 2 + l2; const bf16_t* cp = CN + (size_t)(t0 + lt * 32 + r) * 1024 + g * 128 + 4 * hh;
                    ev[l2] = TE[(size_t)col * 8192 + t0 + lt * 32 + r];
#pragma unroll
                    for (int nt = 0; nt < 4; ++nt)
#pragma unroll
                        for (int q = 0; q < 4; ++q) cl[l2][nt][q] = *(const s16x4*)(cp + nt * 32 + q * 8); }
#pragma unroll
                for (int l2 = 0; l2 < 2; ++l2) { const int lt = lh * 2 + l2;
                    f32x16 y = zero16();
#pragma unroll
                    for (int nt = 0; nt < 4; ++nt) { y = MFMA32(hp[nt][0], cat4(cl[l2][nt][0], cl[l2][nt][1]), y); y = MFMA32(hp[nt][1], cat4(cl[l2][nt][2], cl[l2][nt][3]), y); }
                    store_yT1(y, ev[l2], Y + (size_t)(t0 + lt * 32 + r) * 2048 + head * 64 + pt * 32, hh);
                }
            }
        }
        const float at = ATOT[(t0 >> 7) * 64 + col];
#pragma unroll
        for (int nt = 0; nt < 4; ++nt) H[nt] *= at;
#pragma unroll 1
        for (int kb = 0; kb < 2; ++kb) {
            bf16x8 bfr[4][4]; u32x4 xr[4]; f32x4 w0[4], w1[4];
#pragma unroll
            for (int k4 = 0; k4 < 4; ++k4) { const int so = t0 + (kb * 4 + k4) * 16 + hh * 8;
                xr[k4] = *(const u32x4*)(xrow + so); w0[k4] = *(const f32x4*)(TW + (size_t)col * 8192 + so); w1[k4] = *(const f32x4*)(TW + (size_t)col * 8192 + so + 4);
#pragma unroll
                for (int nt = 0; nt < 4; ++nt) bfr[k4][nt] = *(const bf16x8*)(BT + (size_t)(g * 128 + nt * 32 + r) * 8192 + so); }
#pragma unroll
            for (int k4 = 0; k4 < 4; ++k4) {
                u32x4 xs; xs[0] = pk2(bflo(xr[k4][0]) * w0[k4][0], bfhi(xr[k4][0]) * w0[k4][1]); xs[1] = pk2(bflo(xr[k4][1]) * w0[k4][2], bfhi(xr[k4][1]) * w0[k4][3]);
                xs[2] = pk2(bflo(xr[k4][2]) * w1[k4][0], bfhi(xr[k4][2]) * w1[k4][1]); xs[3] = pk2(bflo(xr[k4][3]) * w1[k4][2], bfhi(xr[k4][3]) * w1[k4][3]);
                const bf16x8 xf = __builtin_bit_cast(bf16x8, xs);
#pragma unroll
                for (int nt = 0; nt < 4; ++nt) H[nt] = MFMA32(bfr[k4][nt], xf, H[nt]);
            }
        }
    }
    if (seq < 16) {
        float* sp = st_out + ((size_t)(seq * 32 + head) * 64) * 128;
#pragma unroll
        for (int nt = 0; nt < 4; ++nt)
#pragma unroll
            for (int g4 = 0; g4 < 4; ++g4) { f32x4 v; v[0] = H[nt][4 * g4]; v[1] = H[nt][4 * g4 + 1]; v[2] = H[nt][4 * g4 + 2]; v[3] = H[nt][4 * g4 + 3];
                *(f32x4*)(sp + (size_t)(pt * 32 + r) * 128 + nt * 32 + 8 * g4 + 4 * hh) = v; }
    }
}

DI void diag_item(int sc, int head, int lt, const bf16_t* __restrict__ XT, const bf16_t* __restrict__ BN, const bf16_t* __restrict__ CN,
                  const float* __restrict__ CUM, const float* __restrict__ DTT, const float* __restrict__ Dskip, bf16_t* __restrict__ Y, int lane) {
    const int r = lane & 31, hh = lane >> 5, g = head >> 2, t0 = sc * 128, l = lt * 32 + r;
    bf16x8 cf[8];
#pragma unroll
    for (int ks = 0; ks < 8; ++ks) cf[ks] = *(const bf16x8*)(CN + (size_t)(t0 + l) * 1024 + g * 128 + ks * 16 + hh * 8);
    const float* cumf = CUM + (size_t)head * 8192 + t0; const float* cumb = CUM + (size_t)(32 + head) * 8192 + t0;
    const float* dtf = DTT + (size_t)head * 8192 + t0; const float* dtb = DTT + (size_t)(32 + head) * 8192 + t0;
    const float cfl = cumf[l], rbl = cumb[l], dsum = dtf[l] + dtb[l];
    f32x16 y0 = zero16(), y1 = zero16();
#pragma unroll 1
    for (int st = 0; st < 4; ++st) {
        bf16x8 bfr[8]; f32x4 cfs[4], dfs[4], rbs[4], dbs[4]; s16x4 xa[2][4];
#pragma unroll
        for (int ks = 0; ks < 8; ++ks) bfr[ks] = *(const bf16x8*)(BN + (size_t)(t0 + st * 32 + r) * 1024 + g * 128 + ks * 16 + hh * 8);
#pragma unroll
        for (int g4 = 0; g4 < 4; ++g4) { const int s0 = st * 32 + 8 * g4 + 4 * hh;
            cfs[g4] = *(const f32x4*)(cumf + s0); dfs[g4] = *(const f32x4*)(dtf + s0); rbs[g4] = *(const f32x4*)(cumb + s0); dbs[g4] = *(const f32x4*)(dtb + s0); }
#pragma unroll
        for (int pt = 0; pt < 2; ++pt) { const bf16_t* ap = XT + (size_t)(head * 64 + pt * 32 + r) * 8192 + t0 + st * 32 + 4 * hh;
#pragma unroll
            for (int q = 0; q < 4; ++q) xa[pt][q] = *(const s16x4*)(ap + q * 8); }
        f32x16 x = zero16();
#pragma unroll
        for (int ks = 0; ks < 8; ++ks) x = MFMA32(bfr[ks], cf[ks], x);
#pragma unroll
        for (int g4 = 0; g4 < 4; ++g4) { const int s0 = st * 32 + 8 * g4 + 4 * hh;
#pragma unroll
            for (int j = 0; j < 4; ++j) { const int sI = s0 + j;
                const float arg = sI < l ? cfl - cfs[g4][j] : rbl - rbs[g4][j];
                const float e = __expf(fminf(arg, 0.f));
                const float val = sI < l ? e * dfs[g4][j] : (sI > l ? e * dbs[g4][j] : dsum);
                x[4 * g4 + j] *= val; } }
        const bf16x8 m0 = pack8<0>(x), m1 = pack8<1>(x);
        y0 = MFMA32(cat4(xa[0][0], xa[0][1]), m0, y0); y0 = MFMA32(cat4(xa[0][2], xa[0][3]), m1, y0);
        y1 = MFMA32(cat4(xa[1][0], xa[1][1]), m0, y1); y1 = MFMA32(cat4(xa[1][2], xa[1][3]), m1, y1);
    }
    const float dsk = Dskip[head];
#pragma unroll
    for (int i = 0; i < 16; ++i) { const int p = (i & 3) + 8 * (i >> 2) + 4 * hh;
        y0[i] += dsk * __uint_as_float((unsigned)XT[(size_t)(head * 64 + p) * 8192 + t0 + l] << 16);
        y1[i] += dsk * __uint_as_float((unsigned)XT[(size_t)(head * 64 + 32 + p) * 8192 + t0 + l] << 16); }
    store_yT1(y0, 1.0f, Y + (size_t)(t0 + l) * 2048 + head * 64, hh); store_yT1(y1, 1.0f, Y + (size_t)(t0 + l) * 2048 + head * 64 + 32, hh);
}

DI void store_yT_wide(const f32x16& y, float sc, bf16_t* __restrict__ yrow  , int hh) {
#pragma unroll
    for (int kp = 0; kp < 2; ++kp) {
        unsigned ax = pk2(y[8 * kp + 0] * sc, y[8 * kp + 1] * sc), ay = pk2(y[8 * kp + 2] * sc, y[8 * kp + 3] * sc);
        unsigned bx = pk2(y[8 * kp + 4] * sc, y[8 * kp + 5] * sc), by = pk2(y[8 * kp + 6] * sc, y[8 * kp + 7] * sc);
        { auto r0 = __builtin_amdgcn_permlane32_swap(ax, bx, false, false); ax = r0[0]; bx = r0[1]; }
        { auto r1 = __builtin_amdgcn_permlane32_swap(ay, by, false, false); ay = r1[0]; by = r1[1]; }
        u32x4 w; w[0] = ax; w[1] = ay; w[2] = bx; w[3] = by;
        *(u32x4*)(yrow + 16 * kp + 8 * hh) = w;
    }
}

constexpr int SB_C = 0, SB_BT = 34816, SB_TE = 69632, SB_TW = 71680, SB_BUF = 73728;
DI void scan_block(int seq, int g, int dir, const bf16_t* __restrict__ XT, const bf16_t* __restrict__ BT, const bf16_t* __restrict__ CN,
                   const float* __restrict__ TE, const float* __restrict__ TW, const float* __restrict__ ATOT, const float* __restrict__ st_in, float* __restrict__ st_out,
                   bf16_t* __restrict__ Y, unsigned char* lds, int tid) {
    asm volatile("" : "+v"(tid));
    const int lane = tid & 63, wv = tid >> 6, r = lane & 31, hh = lane >> 5, hq = wv >> 1, pt = wv & 1, head = g * 4 + hq, col = dir * 32 + head;
    const int T0 = seq < 16 ? seq * 256 : 4096 + (seq - 16) * 1024, nc = seq < 16 ? 2 : 8;
    f32x16 H[4];
    if (seq < 16) {
#pragma unroll
        for (int nt = 0; nt < 4; ++nt) H[nt] = zero16();
    } else {
        const float* sp = st_in + ((size_t)((seq - 16) * 32 + head) * 64) * 128;
#pragma unroll
        for (int nt = 0; nt < 4; ++nt)
#pragma unroll
            for (int g4 = 0; g4 < 4; ++g4) { const f32x4 v = *(const f32x4*)(sp + (size_t)(pt * 32 + r) * 128 + nt * 32 + 8 * g4 + 4 * hh);
                H[nt][4 * g4] = v[0]; H[nt][4 * g4 + 1] = v[1]; H[nt][4 * g4 + 2] = v[2]; H[nt][4 * g4 + 3] = v[3]; }
    }
    const bf16_t* xrow = XT + (size_t)(head * 64 + pt * 32 + r) * 8192;
    const int srow = tid >> 4, sc16 = tid & 15;
    const int tcol = dir * 32 + g * 4 + (tid >> 7), ts = tid & 127;
    u32x4 pC[4], pB[4]; float pte, ptw;
#define SB_STAGE_LOAD(t0_) do { const int t0s = (t0_); _Pragma("unroll") for (int i = 0; i < 4; ++i) { \
        pC[i] = *(const u32x4*)(CN + (size_t)(t0s + srow + 32 * i) * 1024 + g * 128 + sc16 * 8); \
        pB[i] = *(const u32x4*)(BT + (size_t)(g * 128 + srow + 32 * i) * 8192 + t0s + sc16 * 8); } \
        pte = TE[(size_t)tcol * 8192 + t0s + ts]; ptw = TW[(size_t)tcol * 8192 + t0s + ts]; } while (0)
#define SB_STAGE_STORE(L) do { _Pragma("unroll") for (int i = 0; i < 4; ++i) { unsigned char* c_ = (L) + SB_C + (srow + 32 * i) * 272 + (sc16 >> 1) * 32 + (sc16 & 1) * 8; \
        *(u32x2*)c_ = (u32x2){pC[i][0], pC[i][1]}; *(u32x2*)(c_ + 16) = (u32x2){pC[i][2], pC[i][3]}; \
        *(u32x4*)((L) + SB_BT + (srow + 32 * i) * 272 + sc16 * 16) = pB[i]; } \
        ((float*)((L) + SB_TE))[tid] = pte; ((float*)((L) + SB_TW))[tid] = ptw; } while (0)
    SB_STAGE_LOAD(T0 + (dir ? nc - 1 : 0) * 128); SB_STAGE_STORE(lds);
    SB_STAGE_LOAD(T0 + (dir ? nc - 2 : 1) * 128);
    __syncthreads();
#pragma unroll 1
    for (int cc = 0; cc < nc; ++cc) {
        const int c = dir ? nc - 1 - cc : cc, t0 = T0 + c * 128;
        unsigned char* const LB = lds + (cc & 1) * SB_BUF;
        u32x4 xr[8];
#pragma unroll
        for (int ks = 0; ks < 8; ++ks) xr[ks] = *(const u32x4*)(xrow + t0 + ks * 16 + hh * 8);
        const float at = ATOT[(t0 >> 7) * 64 + col];
        __builtin_amdgcn_sched_barrier(0);
        if (cc + 1 < nc) SB_STAGE_STORE(lds + ((cc + 1) & 1) * SB_BUF);
        if (cc + 2 < nc) SB_STAGE_LOAD(T0 + (dir ? nc - 3 - cc : cc + 2) * 128);
        __builtin_amdgcn_sched_barrier(0);
        {
            bf16x8 hp[4][2];
#pragma unroll
            for (int nt = 0; nt < 4; ++nt) { hp[nt][0] = pack8<0>(H[nt]); hp[nt][1] = pack8<1>(H[nt]); }
#pragma unroll
            for (int lt = 0; lt < 4; ++lt) {
                const unsigned char* cp = LB + SB_C + (lt * 32 + r) * 272 + 16 * hh;
                bf16x8 cq[4][2];
#pragma unroll
                for (int nt = 0; nt < 4; ++nt) { cq[nt][0] = *(const bf16x8*)(cp + nt * 64); cq[nt][1] = *(const bf16x8*)(cp + nt * 64 + 32); }
                const float ev = *(const float*)(LB + SB_TE + (hq * 128 + lt * 32 + r) * 4);
                __builtin_amdgcn_sched_barrier(0);
                f32x16 y = zero16();
#pragma unroll
                for (int nt = 0; nt < 4; ++nt) {
                    y = MFMA32(hp[nt][0], cq[nt][0], y); y = MFMA32(hp[nt][1], cq[nt][1], y); }
                store_yT_wide(y, ev, Y + (size_t)(t0 + lt * 32 + r) * 2048 + head * 64 + pt * 32, hh);
            }
        }
#pragma unroll
        for (int nt = 0; nt < 4; ++nt) H[nt] *= at;
#pragma unroll
        for (int kb = 0; kb < 4; ++kb) {
            f32x4 w0[2], w1[2]; bf16x8 bfr[2][4];
#pragma unroll
            for (int k2 = 0; k2 < 2; ++k2) { const int ks = kb * 2 + k2;
                w0[k2] = *(const f32x4*)(LB + SB_TW + (hq * 128 + ks * 16 + hh * 8) * 4); w1[k2] = *(const f32x4*)(LB + SB_TW + (hq * 128 + ks * 16 + hh * 8 + 4) * 4);
#pragma unroll
                for (int nt = 0; nt < 4; ++nt) bfr[k2][nt] = *(const bf16x8*)(LB + SB_BT + (nt * 32 + r) * 272 + ks * 32 + hh * 16); }
            __builtin_amdgcn_sched_barrier(0);
#pragma unroll
            for (int k2 = 0; k2 < 2; ++k2) { const int ks = kb * 2 + k2;
                u32x4 xs; xs[0] = pk2(bflo(xr[ks][0]) * w0[k2][0], bfhi(xr[ks][0]) * w0[k2][1]); xs[1] = pk2(bflo(xr[ks][1]) * w0[k2][2], bfhi(xr[ks][1]) * w0[k2][3]);
                xs[2] = pk2(bflo(xr[ks][2]) * w1[k2][0], bfhi(xr[ks][2]) * w1[k2][1]); xs[3] = pk2(bflo(xr[ks][3]) * w1[k2][2], bfhi(xr[ks][3]) * w1[k2][3]);
                const bf16x8 xf = __builtin_bit_cast(bf16x8, xs);
#pragma unroll
                for (int nt = 0; nt < 4; ++nt) H[nt] = MFMA32(bfr[k2][nt], xf, H[nt]); }
        }
        __syncthreads();
    }
    if (seq < 16) {
        float* sp = st_out + ((size_t)(seq * 32 + head) * 64) * 128;
#pragma unroll
        for (int nt = 0; nt < 4; ++nt)
#pragma unroll
            for (int g4 = 0; g4 < 4; ++g4) { f32x4 v; v[0] = H[nt][4 * g4]; v[1] = H[nt][4 * g4 + 1]; v[2] = H[nt][4 * g4 + 2]; v[3] = H[nt][4 * g4 + 3];
                *(f32x4*)(sp + (size_t)(pt * 32 + r) * 128 + nt * 32 + 8 * g4 + 4 * hh) = v; }
    }
}

constexpr int DB_BN = 0, DB_CN = 34816, DB_XT = 69632, DB_TAB = 139264;
DI void diag_block(int sc, int g, const bf16_t* __restrict__ XT, const bf16_t* __restrict__ BN, const bf16_t* __restrict__ CN,
                   const float* __restrict__ CUM, const float* __restrict__ DTT, const float* __restrict__ Dskip, bf16_t* __restrict__ Y, unsigned char* lds, int tid) {
    asm volatile("" : "+v"(tid));
    const int lane = tid & 63, wv = __builtin_amdgcn_readfirstlane(tid >> 6), r = lane & 31, hh = lane >> 5, lt = wv & 3, hp2 = wv >> 2, t0 = sc * 128, l = lt * 32 + r;
    {
        const int srow = tid >> 4, sc16 = tid & 15;
        u32x4 a[4], b[4], x[8]; float tb[4];
#pragma unroll
        for (int i = 0; i < 4; ++i) { a[i] = *(const u32x4*)(BN + (size_t)(t0 + srow + 32 * i) * 1024 + g * 128 + sc16 * 8); b[i] = *(const u32x4*)(CN + (size_t)(t0 + srow + 32 * i) * 1024 + g * 128 + sc16 * 8); }
#pragma unroll
        for (int i = 0; i < 8; ++i) x[i] = *(const u32x4*)(XT + (size_t)(g * 256 + srow + 32 * i) * 8192 + t0 + sc16 * 8);
#pragma unroll
        for (int i = 0; i < 4; ++i) { const int id = tid + 512 * i, tbl = id >> 9, hq = (id >> 7) & 3, s = id & 127;
            tb[i] = ((tbl & 2) ? DTT : CUM)[(size_t)((tbl & 1) * 32 + g * 4 + hq) * 8192 + t0 + s]; }
#pragma unroll
        for (int i = 0; i < 4; ++i) { *(u32x4*)(lds + DB_BN + (srow + 32 * i) * 272 + sc16 * 16) = a[i]; *(u32x4*)(lds + DB_CN + (srow + 32 * i) * 272 + sc16 * 16) = b[i]; }
#pragma unroll
        for (int i = 0; i < 8; ++i) { unsigned char* q = lds + DB_XT + (srow + 32 * i) * 272 + (sc16 >> 1) * 32 + (sc16 & 1) * 8; *(u32x2*)q = (u32x2){x[i][0], x[i][1]}; *(u32x2*)(q + 16) = (u32x2){x[i][2], x[i][3]}; }
#pragma unroll
        for (int i = 0; i < 4; ++i) ((float*)(lds + DB_TAB))[tid + 512 * i] = tb[i];
    }
    __syncthreads();
    const float* tab = (const float*)(lds + DB_TAB);
    const float dsk0 = Dskip[g * 4 + hp2 * 2], dsk1 = Dskip[g * 4 + hp2 * 2 + 1];
    bf16x8 cf[8];
#pragma unroll
    for (int ks = 0; ks < 8; ++ks) cf[ks] = *(const bf16x8*)(lds + DB_CN + l * 272 + ks * 32 + hh * 16);
    f32x16 y[2][2];
#pragma unroll
    for (int a = 0; a < 2; ++a) { y[a][0] = zero16(); y[a][1] = zero16(); }
    float cfl[2], rbl[2], dsum[2];
#pragma unroll
    for (int a = 0; a < 2; ++a) { const int hq = hp2 * 2 + a; cfl[a] = tab[hq * 128 + l]; rbl[a] = tab[512 + hq * 128 + l]; dsum[a] = tab[1024 + hq * 128 + l] + tab[1536 + hq * 128 + l]; }
#pragma unroll 1
    for (int st = 0; st < 4; ++st) {
        bf16x8 bq[8];
#pragma unroll
        for (int ks = 0; ks < 8; ++ks) bq[ks] = *(const bf16x8*)(lds + DB_BN + (st * 32 + r) * 272 + ks * 32 + hh * 16);
        __builtin_amdgcn_sched_barrier(0);
        f32x16 x = zero16();
#pragma unroll
        for (int ks = 0; ks < 8; ++ks) x = MFMA32(bq[ks], cf[ks], x);
#pragma unroll
        for (int a = 0; a < 2; ++a) { const int hq = hp2 * 2 + a;
            f32x16 xs;
#pragma unroll
            for (int g4 = 0; g4 < 4; ++g4) { const int s0 = st * 32 + 8 * g4 + 4 * hh;
                const f32x4 cfs = *(const f32x4*)(tab + hq * 128 + s0), rbs = *(const f32x4*)(tab + 512 + hq * 128 + s0), dfs = *(const f32x4*)(tab + 1024 + hq * 128 + s0), dbs = *(const f32x4*)(tab + 1536 + hq * 128 + s0);
                if (st == lt) {
#pragma unroll
                    for (int j = 0; j < 4; ++j) { const int sI = s0 + j; const bool lo = sI < l, eq = sI == l;
                        const float arg = lo ? cfl[a] - cfs[j] : rbl[a] - rbs[j];
                        const float e = __expf(fminf(arg, 0.f));
                        const float val = eq ? dsum[a] : e * (lo ? dfs[j] : dbs[j]);
                        xs[4 * g4 + j] = x[4 * g4 + j] * val + (eq ? (a ? dsk1 : dsk0) : 0.f); }
                } else {
                    const bool lo = st < lt;
#pragma unroll
                    for (int j = 0; j < 4; ++j) { const float arg = lo ? cfl[a] - cfs[j] : rbl[a] - rbs[j];
                        xs[4 * g4 + j] = x[4 * g4 + j] * (__expf(fminf(arg, 0.f)) * (lo ? dfs[j] : dbs[j])); }
                } }
            const bf16x8 m0 = pack8<0>(xs), m1 = pack8<1>(xs);
#pragma unroll
            for (int pt = 0; pt < 2; ++pt) { const unsigned char* q = lds + DB_XT + (hq * 64 + pt * 32 + r) * 272 + st * 64 + 16 * hh;
                y[a][pt] = MFMA32(*(const bf16x8*)q, m0, y[a][pt]); y[a][pt] = MFMA32(*(const bf16x8*)(q + 32), m1, y[a][pt]); }
        }
    }
#pragma unroll
    for (int a = 0; a < 2; ++a) { const int head = g * 4 + hp2 * 2 + a;
#pragma unroll
        for (int pt = 0; pt < 2; ++pt) store_yT_wide(y[a][pt], 1.0f, Y + (size_t)(t0 + l) * 2048 + head * 64 + pt * 32, hh); }
    __syncthreads();
}

DI void conv_load(int u, const bf16_t* __restrict__ XBC, const float* __restrict__ cwin, const float* __restrict__ cbin, int tid, u32x4 (&pv)[3], float (&cv)[6]) {
    const int tb = u >> 5, cb = u & 31, T0 = tb * 64, ch0 = cb * 128;
    { const float* cw = cwin + ch0 + (tid & 127); cv[0] = cw[0]; cv[1] = cw[4096]; cv[2] = cw[2 * 4096]; cv[3] = cw[3 * 4096]; cv[4] = cw[4 * 4096]; cv[5] = cbin[ch0 + (tid & 127)]; }
    const int s0 = T0 < 4096 ? (T0 & ~255) : 4096 + ((T0 - 4096) & ~1023), s1 = s0 + (T0 < 4096 ? 256 : 1024);
#pragma unroll
    for (int i = 0; i < 3; ++i) { const int idx = tid + NTHR * i, rr = idx >> 4, c8 = idx & 15, T = T0 - 2 + rr; u32x4 w = {0u, 0u, 0u, 0u};
        if (idx < 68 * 16 && T >= s0 && T < s1) w = *(const u32x4*)(XBC + (size_t)T * 4096 + ch0 + c8 * 8);
        pv[i] = w; }
}
DI void conv_unit(int u, int unext, const bf16_t* __restrict__ XBC, const float* __restrict__ cwin, const float* __restrict__ cbin, bf16_t* __restrict__ XT, bf16_t* __restrict__ BT, bf16_t* __restrict__ BN, bf16_t* __restrict__ CN,
                  bf16_t* Li, bf16_t* Lo, int tid, const u32x4 (&pre)[3], const float (&cwv)[6], u32x4 (&pnext)[3], float (&cnext)[6]) {
    const int tb = u >> 5, cb = u & 31, T0 = tb * 64, ch0 = cb * 128;
#pragma unroll
            for (int i = 0; i < 3; ++i) { const int idx = tid + NTHR * i, rr = idx >> 4, c8 = idx & 15; if (idx < 68 * 16) *(u32x4*)(Li + rr * 136 + c8 * 8) = pre[i]; }
            const float w0 = cwv[0], w1 = cwv[1], w2 = cwv[2], w3 = cwv[3], w4 = cwv[4], bias = cwv[5];
            if (unext < 4096) conv_load(unext, XBC, cwin, cbin, tid, pnext, cnext);
            __syncthreads();
            { const int ch = tid & 127, tg = tid >> 7;
              float x0 = __uint_as_float((unsigned)Li[(tg * 16 + 0) * 136 + ch] << 16), x1 = __uint_as_float((unsigned)Li[(tg * 16 + 1) * 136 + ch] << 16),
                    x2 = __uint_as_float((unsigned)Li[(tg * 16 + 2) * 136 + ch] << 16), x3 = __uint_as_float((unsigned)Li[(tg * 16 + 3) * 136 + ch] << 16);
#pragma unroll
              for (int j = 0; j < 16; ++j) { const float x4 = __uint_as_float((unsigned)Li[(tg * 16 + j + 4) * 136 + ch] << 16);
                  const float y = bias + w0 * x0 + w1 * x1 + w2 * x2 + w3 * x3 + w4 * x4;
                  Lo[(tg * 16 + j) * 136 + ch] = (bf16_t)(pk2(silu(y), 0.f) & 0xffffu);
                  x0 = x1; x1 = x2; x2 = x3; x3 = x4; } }
            __syncthreads();
            if (cb < 24) {
                bf16_t* dst = cb < 16 ? XT + (size_t)ch0 * 8192 + T0 : BT + (size_t)(ch0 - 2048) * 8192 + T0;
                const int ch = tid & 127, tq = tid >> 7; u32x4 a0, a1;
#pragma unroll
                for (int j = 0; j < 4; ++j) { a0[j] = (unsigned)Lo[(tq * 16 + 2 * j) * 136 + ch] | ((unsigned)Lo[(tq * 16 + 2 * j + 1) * 136 + ch] << 16);
                                              a1[j] = (unsigned)Lo[(tq * 16 + 8 + 2 * j) * 136 + ch] | ((unsigned)Lo[(tq * 16 + 8 + 2 * j + 1) * 136 + ch] << 16); }
                bf16_t* dp = dst + (size_t)ch * 8192 + tq * 16; *(u32x4*)dp = a0; *(u32x4*)(dp + 8) = a1;
            }
            if (cb >= 16) {
                bf16_t* dst = cb < 24 ? BN + (ch0 - 2048) : CN + (ch0 - 3072);
#pragma unroll
                for (int i = 0; i < 2; ++i) { const int idx = tid + NTHR * i, rr = idx >> 4, c8 = idx & 15; *(u32x4*)(dst + (size_t)(T0 + rr) * 1024 + c8 * 8) = *(const u32x4*)(Lo + rr * 136 + c8 * 8); }
            }
}

__global__ void __launch_bounds__(NTHR, 2) mega(Params P) {
    extern __shared__ __attribute__((aligned(16))) unsigned char lds[];
    cg::grid_group grid = cg::this_grid();
    const int tid = threadIdx.x, lane = tid & 63, wv = __builtin_amdgcn_readfirstlane(tid >> 6);
    const int G = gridDim.x, bx = blockIdx.x, gw = bx * 8 + wv, nw = G * 8;
    unsigned char* ws = P.ws;
    float* MOD = (float*)(ws + WS_MOD); float* ATOT = (float*)(ws + WS_ATOT);
    float* out = P.out;
    PG8_LAS unsigned char* ldsg = (PG8_LAS unsigned char*)lds;
    unsigned* xbar = (unsigned*)(ws + WS_XBAR);
    volatile LAS unsigned* xst = (volatile LAS unsigned*)(ldsg + 153536 + 16);
    if (tid == 0) { xst[0] = 0u; xst[1] = 0u; }
    __syncthreads();
    XcdBarrier xb = xcd_barrier_post(xbar, xst);
    if (P.ws == nullptr) grid.sync();
#define GRID_BAR() xcd_barrier(xb)

    for (int rep_ = 0; rep_ <= (int)((REPMASK >> 0) & 1u); ++rep_) if (rep_ == 0 || (GRID_BAR(), true))
    {
    if (bx < 192) {
        float* s = (float*)lds;
        for (int i = tid; i < 5 * 1024; i += NTHR) { const int m = i >> 10, k = i & 1023; const float v = (m == 0) ? P.in[7][k] : P.in[2][(m - 1) * 1024 + k]; s[i] = silu(v); }
        __syncthreads();
        const int c4 = tid & 7, kg = tid >> 3, col = bx * 32 + c4 * 4;
        float a[5][4];
#pragma unroll
        for (int m = 0; m < 5; ++m) { a[m][0] = 0.f; a[m][1] = 0.f; a[m][2] = 0.f; a[m][3] = 0.f; }
        const float* wa = P.in[10] + col;
#pragma unroll 4
        for (int i = 0; i < 16; ++i) { const int k = kg + 64 * i; const f32x4 w = *(const f32x4*)(wa + (size_t)k * 6144);
#pragma unroll
            for (int m = 0; m < 5; ++m) { const float sv = s[m * 1024 + k]; a[m][0] += sv * w[0]; a[m][1] += sv * w[1]; a[m][2] += sv * w[2]; a[m][3] += sv * w[3]; } }
        float* red = s + 5120;
#pragma unroll
        for (int m = 0; m < 5; ++m) { f32x4 v; v[0] = a[m][0]; v[1] = a[m][1]; v[2] = a[m][2]; v[3] = a[m][3]; *(f32x4*)(red + (kg * 5 + m) * 32 + c4 * 4) = v; }
        __syncthreads();
        if (tid < 160) { const int m = tid >> 5, cl = tid & 31; float t = 0.f; for (int q = 0; q < 64; ++q) t += red[(q * 5 + m) * 32 + cl]; MOD[m * 6144 + bx * 32 + cl] = t + P.in[11][m * 0 + bx * 32 + cl]; }
        __syncthreads();
    }
    wconv_loop<0>(P.in, ws, 180 * 16, bx, G, lds, tid);
    }
    GRID_BAR();
    for (int rep_ = 0; rep_ <= (int)((REPMASK >> 1) & 1u); ++rep_) if (rep_ == 0 || (GRID_BAR(), true))
    norm_rows(P.in[0], P.in[1], P.in[8], MOD, 0, 1024, (bf16_t*)(ws + WS_HB), gw, nw, lane);
    GRID_BAR();
    for (int rep_ = 0; rep_ <= (int)((REPMASK >> 2) & 1u); ++rep_) if (rep_ == 0 || (GRID_BAR(), true))
    {
        pg8::Gemm g{(const bf16_t*)(ws + WS_HB), (const bf16_t*)(ws + WS_WIN), TOK, 5376, 1024}; pg8::StaticOrder S; S.init(TOK, 5376, G, bx);
        EpiIn1 E{(bf16_t*)(ws + WS_QK), (bf16_t*)(ws + WS_V), (bf16_t*)(ws + WS_G), (float*)(ws + WS_DT), out + 12582912};
        pg8::gemm_phase2<EpiIn1, pg8::StaticOrder, true, true>(ldsg, g, S, E);
        __syncthreads();
        {
            const int nidle = G == 256 ? 96 : G, me = G == 256 ? bx - 160 : bx;
            if (me >= 0) {
                wconv_loop<1>(P.in, ws, 256, me, nidle, lds, tid);
                wconv_loop<1>(P.in, ws, 1024, 768 + me, nidle, lds, tid);
                bf16_t* KNII = (bf16_t*)(ws + WS_KNII);
                for (int i = me * NTHR + tid; i < 262144; i += nidle * NTHR) { const int e = i * 8, d = e & 63, cc = (e >> 6) & 1, hd = (e >> 7) & 7, pq = (e >> 10) & 511, b = e >> 19;
                    const f32x4 a = *(const f32x4*)(P.in[3] + e), c2 = *(const f32x4*)(P.in[3] + e + 4);
                    u32x4 w; w[0] = pk2(a[0], a[1]); w[1] = pk2(a[2], a[3]); w[2] = pk2(c2[0], c2[1]); w[3] = pk2(c2[2], c2[3]);
                    *(u32x4*)(KNII + ((size_t)((b * 8 + hd) * 2 + cc) * 1536 + 1024 + pq) * 64 + d) = w; }
            }
        }
    }
    GRID_BAR();
    for (int rep_ = 0; rep_ <= (int)((REPMASK >> 3) & 1u); ++rep_) if (rep_ == 0 || (GRID_BAR(), true))
    {
        const bf16_t* QK = (const bf16_t*)(ws + WS_QK);
        bf16_t* QN = (bf16_t*)(ws + WS_QN); bf16_t* KNI = (bf16_t*)(ws + WS_KNI); bf16_t* KNII = (bf16_t*)(ws + WS_KNII);
        float* nck = out + 8388608;
        float gq[16], gk[16];
#pragma unroll
        for (int e = 0; e < 16; ++e) { gq[e] = P.in[13][(lane & 3) * 16 + e]; gk[e] = P.in[14][(lane & 3) * 16 + e]; }
        for (int T = gw; T < TOK; T += nw) {
            const int pp = (T - 4096) & 1023, sub = lane & 3;
            const float pos = (float)((sub < 2) ? (pp >> 6) : (pp & 63)), sgn = (lane & 1) ? 1.0f : -1.0f;
            u32x4 rq[2][2];
#pragma unroll
            for (int qk = 0; qk < 2; ++qk) { rq[qk][0] = *(const u32x4*)(QK + (size_t)T * 2048 + qk * 1024 + lane * 16); rq[qk][1] = *(const u32x4*)(QK + (size_t)T * 2048 + qk * 1024 + lane * 16 + 8); }
#pragma unroll
            for (int qk = 0; qk < 2; ++qk) {
                const u32x4 r0 = rq[qk][0], r1 = rq[qk][1];
                float v[16];
#pragma unroll
                for (int j = 0; j < 4; ++j) { v[2 * j] = bflo(r0[j]); v[2 * j + 1] = bfhi(r0[j]); v[8 + 2 * j] = bflo(r1[j]); v[8 + 2 * j + 1] = bfhi(r1[j]); }
                float ss = 0.f;
#pragma unroll
                for (int e = 0; e < 16; ++e) ss += v[e] * v[e];
                ss += __shfl_xor(ss, 1); ss += __shfl_xor(ss, 2);
                const float rs = rsqrtf(ss * (1.0f / 64.0f) + EPSF);
#pragma unroll
                for (int e = 0; e < 16; ++e) v[e] = v[e] * rs * (qk ? gk[e] : gq[e]);
                if (qk == 1 && T < 4096) {
#pragma unroll
                    for (int i = 0; i < 4; ++i) { f32x4 o; o[0] = v[4 * i]; o[1] = v[4 * i + 1]; o[2] = v[4 * i + 2]; o[3] = v[4 * i + 3]; *(f32x4*)(nck + (size_t)T * 1024 + lane * 16 + 4 * i) = o; }
                }
                if (T >= 4096) {
#pragma unroll
                    for (int e = 0; e < 16; ++e) { const float pr = __shfl_xor(v[e], 1);
                        const float inv = __builtin_amdgcn_exp2f(-(float)e * (13.287712379549449f / 16.0f));
                        const float ang = pos * inv; const float sn = __sinf(ang), cs = __cosf(ang);
                        v[e] = v[e] * cs + sgn * pr * sn; }
                }
                if (qk == 0) {
#pragma unroll
                    for (int e = 0; e < 16; ++e) v[e] *= 0.125f * 1.4426950408889634f;
                }
                u32x4 w0, w1;
#pragma unroll
                for (int j = 0; j < 4; ++j) { w0[j] = pk2(v[2 * j], v[2 * j + 1]); w1[j] = pk2(v[8 + 2 * j], v[8 + 2 * j + 1]); }
                const int hd = lane >> 3, cc = (lane >> 2) & 1, d0 = sub * 16;
                bf16_t* dp;
                if (qk == 0) dp = QN + ((size_t)(hd * 2 + cc) * 8192 + T) * 64 + d0;
                else if (T < 4096) dp = KNI + ((size_t)(hd * 2 + cc) * 4096 + T) * 64 + d0;
                else dp = KNII + ((size_t)((((T - 4096) >> 10) * 8 + hd) * 2 + cc) * 1536 + pp) * 64 + d0;
                *(u32x4*)dp = w0; *(u32x4*)(dp + 8) = w1;
            }
        }
        { float* CUM = (float*)(ws + WS_TAB); float* DTT = CUM + TABSZ; float* TE = DTT + TABSZ; float* TW = TE + TABSZ; const float* DT = (const float*)(ws + WS_DT);
          for (int it = gw; it < 4096; it += nw) { const int sc = it >> 6, col = it & 63;
            const float bias = P.in[23][col], A = -__expf(P.in[22][col]);
            const float x0 = DT[(size_t)(sc * 128 + 2 * lane) * 64 + col] + bias, x1 = DT[(size_t)(sc * 128 + 2 * lane + 1) * 64 + col] + bias;
            const float d0 = x0 > 20.f ? x0 : log1pf(__expf(x0)), d1 = x1 > 20.f ? x1 : log1pf(__expf(x1));
            const float a0 = d0 * A, a1 = d1 * A;
            float x = a0 + a1;
#pragma unroll
            for (int o = 1; o < 64; o <<= 1) { const float t = __shfl_up(x, o); if (lane >= o) x += t; }
            const float tot = __shfl(x, 63);
            float c1 = x, c0 = x - a1;
            if (col >= 32) { c0 = tot - c0 + a0; c1 = tot - c1 + a1; }
            const size_t o = (size_t)col * 8192 + sc * 128 + 2 * lane;
            *(f32x2*)(CUM + o) = (f32x2){c0, c1}; *(f32x2*)(DTT + o) = (f32x2){d0, d1};
            *(f32x2*)(TE + o) = (f32x2){__expf(c0), __expf(c1)}; *(f32x2*)(TW + o) = (f32x2){d0 * __expf(tot - c0), d1 * __expf(tot - c1)};
            if (lane == 0) ATOT[sc * 64 + col] = __expf(tot); } }
        { const bf16_t* V = (const bf16_t*)(ws + WS_V); bf16_t* VTI = (bf16_t*)(ws + WS_VTI); bf16_t* VTII = (bf16_t*)(ws + WS_VTII); bf16_t* Ls = (bf16_t*)lds;
          for (int u = bx; u < 1280; u += G) {
            bf16_t* dst; size_t ldd;
            if (u < 1024) { const int tb = u >> 3, hd = u & 7, T0 = tb * 64;
#pragma unroll
                for (int i = 0; i < 2; ++i) { const int idx = tid + NTHR * i, rr = idx >> 4, c8 = idx & 15; *(u32x4*)(Ls + rr * 136 + c8 * 8) = *(const u32x4*)(V + (size_t)(T0 + rr) * 1024 + hd * 128 + c8 * 8); }
                if (T0 < 4096) { dst = VTI + (size_t)hd * 128 * 4096 + T0; ldd = 4096; } else { const int b = (T0 - 4096) >> 10, p0 = (T0 - 4096) & 1023; dst = VTII + (size_t)(b * 8 + hd) * 128 * 1536 + p0; ldd = 1536; }
            } else { const int uu = u - 1024, b = uu >> 6, pb = (uu >> 3) & 7, hd = uu & 7;
#pragma unroll
                for (int i = 0; i < 4; ++i) { const int idx = tid + NTHR * i, rr = idx >> 5, c4 = idx & 31;
                    const f32x4 a = *(const f32x4*)(P.in[4] + ((size_t)((b * 512 + pb * 64 + rr) * 8 + hd)) * 128 + c4 * 4);
                    u32x2 w; w[0] = pk2(a[0], a[1]); w[1] = pk2(a[2], a[3]); *(u32x2*)(Ls + rr * 136 + c4 * 4) = w; }
                dst = VTII + (size_t)(b * 8 + hd) * 128 * 1536 + 1024 + pb * 64; ldd = 1536; }
            __syncthreads();
            { const int vd = tid & 127, tq = tid >> 7; u32x4 w0, w1;
#pragma unroll
              for (int j = 0; j < 4; ++j) { w0[j] = (unsigned)Ls[(tq * 16 + 2 * j) * 136 + vd] | ((unsigned)Ls[(tq * 16 + 2 * j + 1) * 136 + vd] << 16);
                                            w1[j] = (unsigned)Ls[(tq * 16 + 8 + 2 * j) * 136 + vd] | ((unsigned)Ls[(tq * 16 + 8 + 2 * j + 1) * 136 + vd] << 16); }
              bf16_t* dp = dst + (size_t)vd * ldd + tq * 16; *(u32x4*)dp = w0; *(u32x4*)(dp + 8) = w1; }
            __syncthreads();
          } }
    }
    GRID_BAR();
    for (int rep_ = 0; rep_ <= (int)((REPMASK >> 4) & 1u); ++rep_) if (rep_ == 0 || (GRID_BAR(), true))
    {
        const bf16_t* QN = (const bf16_t*)(ws + WS_QN); const bf16_t* KNI = (const bf16_t*)(ws + WS_KNI); const bf16_t* KNII = (const bf16_t*)(ws + WS_KNII);
        const bf16_t* VTI = (const bf16_t*)(ws + WS_VTI); const bf16_t* VTII = (const bf16_t*)(ws + WS_VTII); bf16_t* OATT = (bf16_t*)(ws + WS_OATT);
        const float lam = __expf(wsum(P.in[15][lane] * P.in[16][lane])) - __expf(wsum(P.in[17][lane] * P.in[18][lane])) + 0.2f;
        for (int id0 = bx; id0 < 256; id0 += G) { const int id = ((id0 & 7) * 4 + (id0 >> 6)) * 8 + ((id0 >> 3) & 7);
            const int b = id >> 6, hd = (id >> 3) & 7, qb = id & 7, tok0 = 4096 + b * 1024 + qb * 128;
            attn_unit(QN + ((size_t)(hd * 2) * 8192 + tok0) * 64, QN + ((size_t)(hd * 2 + 1) * 8192 + tok0) * 64,
                      KNII + (size_t)((b * 8 + hd) * 2) * 1536 * 64, KNII + (size_t)((b * 8 + hd) * 2 + 1) * 1536 * 64,
                      VTII + (size_t)(b * 8 + hd) * 128 * 1536, 1536, 1536, OATT + (size_t)tok0 * 1024 + hd * 128, lam, P.in[19], lds, tid); }
        for (int id0 = bx; id0 < 256; id0 += G) { const int id = ((id0 & 7) * 16 + (id0 >> 4)) * 2 + ((id0 >> 3) & 1);
            const int b = id >> 4, hd = (id >> 1) & 7, qb = id & 1, tok0 = b * 256 + qb * 128;
            attn_unit(QN + ((size_t)(hd * 2) * 8192 + tok0) * 64, QN + ((size_t)(hd * 2 + 1) * 8192 + tok0) * 64,
                      KNI + ((size_t)(hd * 2) * 4096 + b * 256) * 64, KNI + ((size_t)(hd * 2 + 1) * 4096 + b * 256) * 64,
                      VTI + (size_t)hd * 128 * 4096 + b * 256, 4096, 256, OATT + (size_t)tok0 * 1024 + hd * 128, lam, P.in[19], lds, tid); }
    }
    GRID_BAR();
    for (int rep_ = 0; rep_ <= (int)((REPMASK >> 5) & 1u); ++rep_) if (rep_ == 0 || (GRID_BAR(), true))
    {
        pg8::Gemm g{(const bf16_t*)(ws + WS_HB), (const bf16_t*)(ws + WS_WIN) + (size_t)5376 * 1024, TOK, 6144, 1024}; pg8::StaticOrder S; S.init(TOK, 6144, G, bx);
        EpiIn2 E{(bf16_t*)(ws + WS_Z), (bf16_t*)(ws + WS_XBC)};
        pg8::gemm_phase2<EpiIn2, pg8::StaticOrder, true, true>(ldsg, g, S, E);
    }
    GRID_BAR();
    for (int rep_ = 0; rep_ <= (int)((REPMASK >> 6) & 1u); ++rep_) if (rep_ == 0 || (GRID_BAR(), true))
    {
        const bf16_t* XBC = (const bf16_t*)(ws + WS_XBC); bf16_t* XT = (bf16_t*)out; bf16_t* BT = (bf16_t*)(ws + WS_BT); bf16_t* BN = (bf16_t*)(ws + WS_BN); bf16_t* CN = (bf16_t*)(ws + WS_CN);
        bf16_t* Li = (bf16_t*)lds;
        bf16_t* Lo = Li + 68 * 136;
        const float* cwin = P.in[20]; const float* cbin = P.in[21];
        u32x4 pa[3], pb[3], pc[3]; float ca[6], cbv[6], cc[6];
        if (bx < 4096) conv_load(bx, XBC, cwin, cbin, tid, pa, ca);
        if (bx + G < 4096) conv_load(bx + G, XBC, cwin, cbin, tid, pb, cbv);
        for (int u = bx; u < 4096; u += 3 * G) {
            conv_unit(u, u + 2 * G, XBC, cwin, cbin, XT, BT, BN, CN, Li, Lo, tid, pa, ca, pc, cc);
            if (u + G < 4096) conv_unit(u + G, u + 3 * G, XBC, cwin, cbin, XT, BT, BN, CN, Li, Lo, tid, pb, cbv, pa, ca);
            if (u + 2 * G < 4096) conv_unit(u + 2 * G, u + 4 * G, XBC, cwin, cbin, XT, BT, BN, CN, Li, Lo, tid, pc, cc, pb, cbv);
        }
    }
    GRID_BAR();
    for (int rep_ = 0; rep_ <= (int)((REPMASK >> 7) & 1u); ++rep_) if (rep_ == 0 || (GRID_BAR(), true))
    {
        const bf16_t* XT = (const bf16_t*)out; const bf16_t* BT = (const bf16_t*)(ws + WS_BT); const bf16_t* BN = (const bf16_t*)(ws + WS_BN); const bf16_t* CN = (const bf16_t*)(ws + WS_CN);
        const float* CUM = (const float*)(ws + WS_TAB); const float* DTT = CUM + TABSZ; const float* TE = DTT + TABSZ; const float* TW = TE + TABSZ;
        bf16_t* YD = (bf16_t*)(ws + WS_YD); bf16_t* YF = (bf16_t*)(ws + WS_YF); bf16_t* YB = (bf16_t*)(ws + WS_YB);
        unsigned* gq = (unsigned*)(ws + WS_QCNT); int* slot = (int*)(lds + 153536);
        for (int id = bx; id < 64; id += G)
            scan_block(16 + (id >> 4), (id >> 1) & 7, id & 1, XT, BT, CN, TE, TW, ATOT, (id & 1) ? P.in[6] : P.in[5], out + ((id & 1) ? 20971520 : 16777216), (id & 1) ? YB : YF, lds, tid);
        {
            for (;;) {
                if (tid == 0) *slot = (int)atomicAdd(gq, 1u);
                __syncthreads();
                const int id = *slot;
                __syncthreads();
                if (id >= 768) break;
                if (id < 512) diag_block(id >> 3, id & 7, XT, BN, CN, CUM, DTT, P.in[24], YD, lds, tid);
                else { const int is = id - 512; scan_block(is >> 4, (is >> 1) & 7, is & 1, XT, BT, CN, TE, TW, ATOT, (is & 1) ? P.in[6] : P.in[5], out + ((is & 1) ? 20971520 : 16777216), (is & 1) ? YB : YF, lds, tid); }
            }
        }
    }
    GRID_BAR();
    for (int rep_ = 0; rep_ <= (int)((REPMASK >> 8) & 1u); ++rep_) if (rep_ == 0 || (GRID_BAR(), true))
    {
        const bf16_t* YD = (const bf16_t*)(ws + WS_YD); const bf16_t* YF = (const bf16_t*)(ws + WS_YF); const bf16_t* YB = (const bf16_t*)(ws + WS_YB); const bf16_t* Z = (const bf16_t*)(ws + WS_Z);
        bf16_t* YG = (bf16_t*)(ws + WS_YG);
        f32x4 gn[8];
#pragma unroll
        for (int i = 0; i < 8; ++i) gn[i] = *(const f32x4*)(P.in[25] + lane * 32 + i * 4);
#pragma unroll 2
        for (int row = gw; row < TOK; row += nw) {
            float u[32]; float ss = 0.f;
#pragma unroll
            for (int i = 0; i < 4; ++i) { const size_t o = (size_t)row * 2048 + lane * 32 + i * 8;
                const u32x4 a = *(const u32x4*)(YD + o), b = *(const u32x4*)(YF + o), c = *(const u32x4*)(YB + o), z = *(const u32x4*)(Z + o);
#pragma unroll
                for (int j = 0; j < 4; ++j) { const float y0 = bflo(a[j]) + bflo(b[j]) + bflo(c[j]), y1 = bfhi(a[j]) + bfhi(b[j]) + bfhi(c[j]);
                    const float t0 = y0 * silu(bflo(z[j])), t1 = y1 * silu(bfhi(z[j])); u[i * 8 + 2 * j] = t0; u[i * 8 + 2 * j + 1] = t1; ss += t0 * t0 + t1 * t1; } }
            ss = wsum(ss);
            const float rstd = rsqrtf(ss * (1.0f / 2048.0f) + EPSF);
#pragma unroll
            for (int i = 0; i < 4; ++i) { const int c = lane * 32 + i * 8; const f32x4 g0 = gn[2 * i], g1 = gn[2 * i + 1];
                u32x4 w; w[0] = pk2(u[i * 8] * rstd * g0[0], u[i * 8 + 1] * rstd * g0[1]); w[1] = pk2(u[i * 8 + 2] * rstd * g0[2], u[i * 8 + 3] * rstd * g0[3]);
                w[2] = pk2(u[i * 8 + 4] * rstd * g1[0], u[i * 8 + 5] * rstd * g1[1]); w[3] = pk2(u[i * 8 + 6] * rstd * g1[2], u[i * 8 + 7] * rstd * g1[3]);
                *(u32x4*)(YG + (size_t)row * 2048 + c) = w; }
        }
        wconv_loop<1>(P.in, ws, 768, 256 + bx, G, lds, tid);
    }
    GRID_BAR();
    for (int rep_ = 0; rep_ <= (int)((REPMASK >> 9) & 1u); ++rep_) if (rep_ == 0 || (GRID_BAR(), true))
    {
        pg8::StaticOrder S; S.init(2 * TOK, 1024, G, bx);
        u32x4 keepb[8];
#pragma unroll
        for (int i = 0; i < 8; ++i) keepb[i] = (u32x4){0u, 0u, 0u, 0u};
        { pg8::Gemm g{(const bf16_t*)(ws + WS_YG), (const bf16_t*)(ws + WS_WB), TOK, 1024, 2048};
          EpiBranch<1, 1> E{(const bf16_t*)(ws + WS_G), (bf16_t*)(ws + WS_MA), keepb};
          pg8::gemm_phase2<EpiBranch<1, 1>, pg8::StaticOrder, true, true, true>(ldsg, g, S, E); }
        __syncthreads();
        { pg8::Gemm g{(const bf16_t*)(ws + WS_OATT), (const bf16_t*)(ws + WS_WA), TOK, 1024, 1024};
          EpiBranch<0, 1> E{(const bf16_t*)(ws + WS_G), (bf16_t*)(ws + WS_MA), keepb};
          pg8::gemm_phase2<EpiBranch<0, 1>, pg8::StaticOrder, true, true, true>(ldsg, g, S, E); }
    }
    GRID_BAR();
    for (int rep_ = 0; rep_ <= (int)((REPMASK >> 10) & 1u); ++rep_) if (rep_ == 0 || (GRID_BAR(), true))
    {
        pg8::Gemm g{(const bf16_t*)(ws + WS_MA), (const bf16_t*)(ws + WS_WOUT), TOK, 1024, 1024}; pg8::StaticOrder S; S.init(2 * TOK, 1024, G, bx);
        EpiRes<0, 1> E{P.in[0], P.in[1], MOD, out};
        pg8::gemm_phase2<EpiRes<0, 1>, pg8::StaticOrder, true, true, true>(ldsg, g, S, E);
    }
    GRID_BAR();
    for (int rep_ = 0; rep_ <= (int)((REPMASK >> 11) & 1u); ++rep_) if (rep_ == 0 || (GRID_BAR(), true))
    { norm_rows(out, out + (size_t)4096 * 1024, P.in[9], MOD, 3072, 4096, (bf16_t*)(ws + WS_H2), gw, nw, lane);
      wconv_loop<2>(P.in, ws, 1408, bx, G, lds, tid); }
    GRID_BAR();
    for (int rep_ = 0; rep_ <= (int)((REPMASK >> 12) & 1u); ++rep_) if (rep_ == 0 || (GRID_BAR(), true))
    {
        pg8::Gemm g{(const bf16_t*)(ws + WS_H2), (const bf16_t*)(ws + WS_WGU), TOK, 5632, 1024}; pg8::StaticOrder S; S.init(TOK, 5632, G, bx);
        EpiUp E{(bf16_t*)(ws + WS_ACT)};
        pg8::gemm_phase2<EpiUp, pg8::StaticOrder, true, true>(ldsg, g, S, E);
        __syncthreads();
        if (G == 256) { if (bx >= 192) wconv_loop<2>(P.in, ws, 2112, 1408 + (bx - 192), 64, lds, tid); }
        else wconv_loop<2>(P.in, ws, 2112, 1408 + bx, G, lds, tid);
    }
    GRID_BAR();
    for (int rep_ = 0; rep_ <= (int)((REPMASK >> 13) & 1u); ++rep_) if (rep_ == 0 || (GRID_BAR(), true))
    {
        pg8::Gemm g{(const bf16_t*)(ws + WS_ACT), (const bf16_t*)(ws + WS_WD), TOK, 1024, 2816}; pg8::StaticOrder S; S.init(2 * TOK, 1024, G, bx);
        EpiRes<1, 1> E{P.in[0], P.in[1], MOD, out};
        pg8::gemm_phase2<EpiRes<1, 1>, pg8::StaticOrder, true, true, true>(ldsg, g, S, E);
    }
}

extern "C" void kernel_launch(void* const* d_in, const int* in_sizes, int n_in, void* d_out, int out_size, void* d_ws, size_t ws_size, hipStream_t stream) {
    static int grid = 0;
    if (grid == 0) {
        int dev = 0, cus = 0, per_cu = 0;
        (void)hipGetDevice(&dev);
        (void)hipDeviceGetAttribute(&cus, hipDeviceAttributeMultiprocessorCount, dev);
        if (hipFuncSetAttribute((const void*)mega, hipFuncAttributeMaxDynamicSharedMemorySize, LDS_BYTES) != hipSuccess) fprintf(stderr, "kernel_launch: hipFuncSetAttribute failed\n");
        if (hipOccupancyMaxActiveBlocksPerMultiprocessor(&per_cu, (const void*)mega, NTHR, LDS_BYTES) != hipSuccess || per_cu < 1) { fprintf(stderr, "kernel_launch: occupancy query says %d blocks/CU\n", per_cu); per_cu = 1; }
        (void)hipGetLastError();
        grid = cus > 256 ? 256 : cus;
        if (ws_size < 256 * MiB) fprintf(stderr, "kernel_launch: workspace too small: %zu\n", ws_size);
    }
    Params p{};
    for (int i = 0; i < 32; ++i) p.in[i] = (const float*)d_in[i];
    p.out = (float*)d_out; p.ws = (unsigned char*)d_ws;
    (void)hipMemsetAsync((unsigned char*)d_ws + WS_XBAR, 0, 262144, stream);
    void* args[] = {&p};
    hipError_t e = hipLaunchCooperativeKernel((const void*)mega, dim3(grid), dim3(NTHR), args, LDS_BYTES, stream);
    if (e != hipSuccess) fprintf(stderr, "kernel_launch: cooperative launch failed: %s (grid %d)\n", hipGetErrorString(e), grid);
}
```
